# Optimizing an MI355X kernel written in HIP

```python
import jax, jax.numpy as jnp
from jax import lax
import numpy as np

D_MODEL = 1024
BATCH = 8
SEQ = 8192
DEPTH = 1
DEC_BATCH = 32
DEC_SEQ = 32
PAST_LEN = 2048

CHUNK = 64
Q_BLOCK = 128
N_HEADS = 8
QK_NOPE = 64
QK_ROPE = 32
V_HEAD = 64
KV_LORA = 256
Q_LORA = 768
D_ATTN = N_HEADS * V_HEAD
D_CONV = 512
CONV_W = 3
D_MIX = D_ATTN + D_CONV
D_IN_PROJ = Q_LORA + KV_LORA + QK_ROPE + 3 * D_CONV
D_FF = ((8 * D_MODEL + 3 * 256 - 1) // (3 * 256)) * 256
ROPE_THETA = 10000.0
EPS = 1e-6
SM_SCALE = (QK_NOPE + QK_ROPE) ** -0.5

kernel_name = "hybrid_mla_shortconv_streaming_step"


def rms_norm(x, g):
    xf = x.astype(jnp.float32)
    y = xf * lax.rsqrt(jnp.mean(jnp.square(xf), axis=-1, keepdims=True) + EPS)
    return (y * g.astype(jnp.float32)).astype(x.dtype)


def apply_rope(x, pos):
    half = QK_ROPE // 2
    inv_freq = ROPE_THETA ** (-jnp.arange(half, dtype=jnp.float32) / half)
    ang = pos.astype(jnp.float32)[:, None] * inv_freq[None, :]
    cos = jnp.cos(ang)[None, :, None, :]
    sin = jnp.sin(ang)[None, :, None, :]
    xf = x.astype(jnp.float32)
    x1, x2 = xf[..., :half], xf[..., half:]
    return jnp.concatenate([x1 * cos - x2 * sin, x1 * sin + x2 * cos], axis=-1).astype(x.dtype)


def attend(q_nope, q_rope, q_pos, k_nope, k_rope, v, k_pos):
    s = (jnp.einsum("bqhd,bkhd->bhqk", q_nope, k_nope)
         + jnp.einsum("bqhr,bkr->bhqk", q_rope, k_rope)).astype(jnp.float32) * SM_SCALE
    allowed = (k_pos[None, :] // CHUNK) <= (q_pos[:, None] // CHUNK)
    s = jnp.where(allowed[None, None], s, jnp.finfo(jnp.float32).min)
    p = jax.nn.softmax(s, axis=-1).astype(v.dtype)
    return jnp.einsum("bhqk,bkhd->bqhd", p, v)


def chunk_causal_attention(q_nope, q_rope, q_pos, k_nope, k_rope, v, k_pos):
    B, S = q_nope.shape[0], q_nope.shape[1]
    if S <= Q_BLOCK:
        return attend(q_nope, q_rope, q_pos, k_nope, k_rope, v, k_pos)
    nb = S // Q_BLOCK

    def to_blocks(t):
        return jnp.moveaxis(t.reshape(B, nb, Q_BLOCK, *t.shape[2:]), 1, 0)

    qp = q_pos.reshape(nb, Q_BLOCK)
    out = lax.map(lambda a: attend(a[0], a[1], a[2], k_nope, k_rope, v, k_pos),
                  (to_blocks(q_nope), to_blocks(q_rope), qp))
    return jnp.moveaxis(out, 0, 1).reshape(B, S, N_HEADS, V_HEAD)


def hybrid_mixer(h, pos, past_latent, past_k_rope, conv_prev,
                 w_in, q_norm_g, w_uq, kv_norm_g, w_ukv, conv_w, conv_b, w_out):
    B, S, _ = h.shape
    proj = h @ w_in
    i1 = Q_LORA
    i2 = i1 + KV_LORA
    i3 = i2 + QK_ROPE
    i4 = i3 + D_CONV
    i5 = i4 + D_CONV
    c_q, c_kv, k_r, u, g_b, g_c = jnp.split(proj, [i1, i2, i3, i4, i5], axis=-1)

    q = (rms_norm(c_q, q_norm_g) @ w_uq).reshape(B, S, N_HEADS, QK_NOPE + QK_ROPE)
    q_nope = q[..., :QK_NOPE]
    q_rope = apply_rope(q[..., QK_NOPE:], pos)
    latent = rms_norm(c_kv, kv_norm_g)
    k_rope_new = apply_rope(k_r[:, :, None, :], pos)[:, :, 0, :]
    if past_latent is None:
        all_latent, all_k_rope, k_pos = latent, k_rope_new, pos
    else:
        P = past_latent.shape[1]
        all_latent = jnp.concatenate([past_latent, latent], axis=1)
        all_k_rope = jnp.concatenate([past_k_rope, k_rope_new], axis=1)
        k_pos = jnp.concatenate([jnp.arange(P, dtype=jnp.int32), pos])
    T = all_latent.shape[1]
    kv = (all_latent @ w_ukv).reshape(B, T, N_HEADS, QK_NOPE + V_HEAD)
    k_nope, v = kv[..., :QK_NOPE], kv[..., QK_NOPE:]
    attn = chunk_causal_attention(q_nope, q_rope, pos, k_nope, all_k_rope, v, k_pos)

    gated_in = g_c * u
    ext = jnp.concatenate([conv_prev, gated_in], axis=1)
    conv = (conv_w[0] * ext[:, :S] + conv_w[1] * ext[:, 1:S + 1]
            + conv_w[2] * ext[:, 2:S + 2] + conv_b)
    y_conv = g_b * conv

    mix = jnp.concatenate([attn.reshape(B, S, D_ATTN), y_conv], axis=-1) @ w_out
    return mix, latent, k_rope_new, ext[:, S:]


def layer(x, c, pos, past_latent, past_k_rope, conv_prev,
          w_ada, b_ada, norm_mix_g, w_in, q_norm_g, w_uq, kv_norm_g, w_ukv,
          conv_w, conv_b, w_out, norm_ffn_g, w_gate, w_up, w_down):
    mod = jax.nn.silu(c) @ w_ada + b_ada
    sh1, sc1, g1, sh2, sc2, g2 = jnp.split(mod[:, None, :], 6, axis=-1)
    h = rms_norm(x, norm_mix_g) * (1 + sc1) + sh1
    mix, latent, k_rope_new, conv_state = hybrid_mixer(
        h, pos, past_latent, past_k_rope, conv_prev,
        w_in, q_norm_g, w_uq, kv_norm_g, w_ukv, conv_w, conv_b, w_out)
    x = x + g1 * mix
    h = rms_norm(x, norm_ffn_g) * (1 + sc2) + sh2
    ff = (jax.nn.silu(h @ w_gate) * (h @ w_up)) @ w_down
    x = x + g2 * ff
    return x, latent, k_rope_new, conv_state


def setup_inputs(seed: int = 0) -> dict:
    key = jax.random.key(seed)
    ks = jax.random.split(key, 24)

    def nrm(k, shape, s):
        return jax.random.normal(k, shape, jnp.float32) * s

    return {
        "x_prompt": nrm(ks[0], (BATCH, SEQ, D_MODEL), 1.0),
        "x_sample": nrm(ks[1], (DEC_BATCH, DEC_SEQ, D_MODEL), 1.0),
        "c_prompt": nrm(ks[2], (BATCH, D_MODEL), 1.0),
        "c_sample": nrm(ks[3], (DEC_BATCH, D_MODEL), 1.0),
        "cache_kv_latent": nrm(ks[4], (DEPTH, DEC_BATCH, PAST_LEN, KV_LORA), 1.0),
        "cache_k_rope": nrm(ks[5], (DEPTH, DEC_BATCH, PAST_LEN, QK_ROPE), 1.0),
        "state_conv": nrm(ks[6], (DEPTH, DEC_BATCH, CONV_W - 1, D_CONV), 0.5),
        "w_ada": nrm(ks[7], (DEPTH, D_MODEL, 6 * D_MODEL), 0.5 * D_MODEL ** -0.5),
        "b_ada": nrm(ks[8], (DEPTH, 6 * D_MODEL), 0.02),
        "norm_mix_g": 1.0 + nrm(ks[9], (DEPTH, D_MODEL), 0.02),
        "w_in": nrm(ks[10], (DEPTH, D_MODEL, D_IN_PROJ), D_MODEL ** -0.5),
        "q_norm_g": 1.0 + nrm(ks[11], (DEPTH, Q_LORA), 0.02),
        "w_uq": nrm(ks[12], (DEPTH, Q_LORA, N_HEADS * (QK_NOPE + QK_ROPE)), Q_LORA ** -0.5),
        "kv_norm_g": 1.0 + nrm(ks[13], (DEPTH, KV_LORA), 0.02),
        "w_ukv": nrm(ks[14], (DEPTH, KV_LORA, N_HEADS * (QK_NOPE + V_HEAD)), KV_LORA ** -0.5),
        "conv_w": nrm(ks[15], (DEPTH, CONV_W, D_CONV), CONV_W ** -0.5),
        "conv_b": nrm(ks[16], (DEPTH, D_CONV), 0.02),
        "w_out": nrm(ks[17], (DEPTH, D_MIX, D_MODEL), D_MIX ** -0.5),
        "norm_ffn_g": 1.0 + nrm(ks[18], (DEPTH, D_MODEL), 0.02),
        "w_gate": nrm(ks[19], (DEPTH, D_MODEL, D_FF), D_MODEL ** -0.5),
        "w_up": nrm(ks[20], (DEPTH, D_MODEL, D_FF), D_MODEL ** -0.5),
        "w_down": nrm(ks[21], (DEPTH, D_FF, D_MODEL), D_FF ** -0.5),
        "final_norm_g": 1.0 + nrm(ks[22], (D_MODEL,), 0.02),
    }


def reference(x_prompt, x_sample, c_prompt, c_sample, cache_kv_latent, cache_k_rope, state_conv,
              w_ada, b_ada, norm_mix_g, w_in, q_norm_g, w_uq, kv_norm_g, w_ukv,
              conv_w, conv_b, w_out, norm_ffn_g, w_gate, w_up, w_down, final_norm_g):
    S = x_prompt.shape[1]
    P = cache_kv_latent.shape[2]
    Sd = x_sample.shape[1]
    pos_p = jnp.arange(S, dtype=jnp.int32)
    pos_s = P + jnp.arange(Sd, dtype=jnp.int32)
    conv_zero = jnp.zeros((x_prompt.shape[0], CONV_W - 1, D_CONV), x_prompt.dtype)

    xp, xs = x_prompt, x_sample
    lat_p, kr_p, cv_p, lat_s, kr_s, cv_s = [], [], [], [], [], []
    for l in range(DEPTH):
        w = (w_ada[l], b_ada[l], norm_mix_g[l], w_in[l], q_norm_g[l], w_uq[l], kv_norm_g[l], w_ukv[l],
             conv_w[l], conv_b[l], w_out[l], norm_ffn_g[l], w_gate[l], w_up[l], w_down[l])
        xp, a, b, c = layer(xp, c_prompt, pos_p, None, None, conv_zero, *w)
        lat_p.append(a)
        kr_p.append(b)
        cv_p.append(c)
        xs, a, b, c = layer(xs, c_sample, pos_s, cache_kv_latent[l], cache_k_rope[l], state_conv[l], *w)
        lat_s.append(a)
        kr_s.append(b)
        cv_s.append(c)

    y_prompt = rms_norm(xp, final_norm_g)
    y_sample = rms_norm(xs, final_norm_g)
    new_latent_p = jnp.stack(lat_p)
    new_k_rope_p = jnp.stack(kr_p)
    new_conv_p = jnp.stack(cv_p)
    new_latent_s = jnp.stack(lat_s)
    new_k_rope_s = jnp.stack(kr_s)
    new_conv_s = jnp.stack(cv_s)
    return (y_prompt, y_sample, new_latent_p, new_k_rope_p, new_conv_p, new_latent_s, new_k_rope_s, new_conv_s)
```

```cpp
#include <hip/hip_runtime.h>
#include <hip/hip_cooperative_groups.h>
#include <cstdio>
#include <cstdint>
#include <cmath>
namespace cg = cooperative_groups;
namespace pg8 {
#define PG8_LAS __attribute__((address_space(3)))
typedef unsigned short bf16_t;
typedef short bf16x8 __attribute__((ext_vector_type(8)));
typedef float f32x4 __attribute__((ext_vector_type(4)));
typedef unsigned u32x4 __attribute__((ext_vector_type(4)));
constexpr int BM = 256, BK = 64, HALF = 128, HTB = HALF * BK * 2  , STAGE_BYTES = 8 * HTB, NXCD = 8, WGM = 8;

__host__ __device__ __forceinline__ int lds_byte(int r, int c) { const int st = (r >> 4) * 2 + (c >> 5), rr = r & 15, cc = c & 31, ob = rr * 64 + cc * 2; return st * 1024 + (ob ^ (((ob >> 9) & 1) << 5)); }
__host__ __device__ __forceinline__ void stage_rc(int b, int& R, int& C) { const int st = b / 1024, sb = b % 1024, swz = sb ^ (((sb >> 9) & 1) << 5); R = (st >> 1) * 16 + swz / 64; C = (st & 1) * 32 + (swz % 64) / 2; }
__host__ __device__ __forceinline__ int perm32(int rho) { const int n = rho >> 4, i = rho & 15; return 8 * (i >> 2) + 4 * n + (i & 3); }

struct Unit { int pm, pn, kc; };
struct Gemm { const bf16_t* A; const bf16_t* Bt; int M, N, K, ld; };

struct StaticOrder {
    int nM, nN, nwg, G, c, split, rev, revn;
    __host__ __device__ void init(int M, int N, int G_, int c_) { nM = M / BM; nN = N / BM; nwg = nM * nN; G = G_; c = c_; split = 0; rev = 0; revn = 0; }
    __host__ __device__ bool next(int i, Unit& u) const {
        u.kc = 0;
        if (split) { if (i != 0 || c >= split * nwg) return false; u.kc = c / nwg; const int r = c % nwg; u.pm = r / nN; u.pn = r % nN; return true; }
        const long L = (long)i * G + c; if (L >= nwg) return false;
        int wgid = (int)L; { const int q = nwg / NXCD, r = nwg % NXCD, xcd = wgid % NXCD, off = wgid / NXCD; wgid = (xcd < r ? xcd * (q + 1) : r * (q + 1) + (xcd - r) * q) + off; }
        const int nig = WGM * nN, gid = wgid / nig, fm = gid * WGM, gsz = (nM - fm) < WGM ? (nM - fm) : WGM;
        u.pm = fm + ((wgid % nig) % gsz); u.pn = (wgid % nig) / gsz; if (rev) u.pm = nM - 1 - u.pm; if (revn) u.pn = nN - 1 - u.pn; return true;
    }
    __device__ __forceinline__ void a_ready(const Unit&) const {}
    __device__ __forceinline__ void done(const Unit&) const {}
};
__device__ __forceinline__ unsigned cvt_pk_bf16(float lo, float hi) { unsigned r; asm volatile("v_cvt_pk_bf16_f32 %0, %1, %2" : "=v"(r) : "v"(lo), "v"(hi)); return r; }
template <class Epi, class Sched, bool ALIGN_EPI = false, bool SP2 = false>
__device__ __forceinline__ void gemm_phase(PG8_LAS unsigned char* lds, const Gemm g, const Sched& S, const Epi& E) {
    int tid_ = threadIdx.x; asm volatile("" : "+v"(tid_));
    const int tid = tid_, wid = __builtin_amdgcn_readfirstlane(tid >> 6), lane = tid & 63, wr = wid >> 2, wc = wid & 3, fr = lane & 15, fq = lane >> 4;
    const int K = g.K, nt = K / BK;
    unsigned voffA[2], voffB[2];
#pragma unroll
    for (int i = 0; i < 2; ++i) { int R, C; stage_rc(tid * 16 + i * 8192, R, C); const int Rb = Epi::PERM ? ((R & ~31) + perm32(R & 31)) : R;
        voffA[i] = (unsigned)(R * g.ld + C) * 2u; voffB[i] = (unsigned)(Rb * g.ld + C) * 2u; }
    const size_t kstep = (size_t)(BK * 2);
    const size_t hstep = (size_t)HALF * g.ld * 2;
    const size_t tstep = 2 * hstep;
    const unsigned ldsw = (unsigned)wid * 1024u;
    const int aoff = lds_byte(wr * 64 + fr, fq * 8), boff = lds_byte(wc * 32 + fr, fq * 8);
#define PG8_SA(b, h) (((b) * 2 + (h)) * HTB)
#define PG8_SB(b, h) ((4 + (b) * 2 + (h)) * HTB)
#define PG8_STAGE(bufoff, gbase, voff) do { _Pragma("unroll") for (int _i = 0; _i < 2; ++_i) \
        __builtin_amdgcn_global_load_lds((const unsigned*)((const char*)(gbase) + (voff)[_i]), (PG8_LAS unsigned*)(lds + (bufoff) + ldsw + _i * 8192), 16, 0, 0); } while (0)
#define PG8_LDA(dst, b, h) do { _Pragma("unroll") for (int m = 0; m < 4; ++m) _Pragma("unroll") for (int k = 0; k < 2; ++k) dst[m][k] = *(const PG8_LAS bf16x8*)(lds + PG8_SA(b, h) + aoff + m * 2048 + k * 1024); } while (0)
#define PG8_LDB(dst, b, h) do { _Pragma("unroll") for (int n = 0; n < 2; ++n) _Pragma("unroll") for (int k = 0; k < 2; ++k) dst[n][k] = *(const PG8_LAS bf16x8*)(lds + PG8_SB(b, h) + boff + n * 2048 + k * 1024); } while (0)
#define PG8_MMA(ai, bj, At, Bt) do { __builtin_amdgcn_s_setprio(1); _Pragma("unroll") for (int m = 0; m < 4; ++m) _Pragma("unroll") for (int n = 0; n < 2; ++n) _Pragma("unroll") for (int k = 0; k < 2; ++k) \
        acc[ai][bj][m][n] = __builtin_amdgcn_mfma_f32_16x16x32_bf16(Bt[n][k], At[m][k], acc[ai][bj][m][n], 0, 0, 0); __builtin_amdgcn_s_setprio(0); } while (0)
#define PG8_WAIT_V(n) asm volatile("s_waitcnt vmcnt(" #n ")" ::: "memory")
#define PG8_WAIT_L(n) asm volatile("s_waitcnt lgkmcnt(" #n ")" ::: "memory")
#define PG8_BAR __builtin_amdgcn_s_barrier()
#define PG8_SCHED __builtin_amdgcn_sched_barrier(0)
    Unit cur, nxt; int ui = 0;
    if (!S.next(0, cur)) return;
    f32x4 acc[2][2][4][2];
#pragma unroll
    for (int a = 0; a < 2; ++a)
#pragma unroll
        for (int b = 0; b < 2; ++b)
#pragma unroll
            for (int m = 0; m < 4; ++m)
#pragma unroll
                for (int n = 0; n < 2; ++n) acc[a][b][m][n] = (f32x4){0.f, 0.f, 0.f, 0.f};
    bf16x8 At[4][2], B0[2][2], B1[2][2];
    const char* cA = (const char*)g.A + (size_t)cur.pm * tstep + (size_t)cur.kc * K * 2; const char* cB = (const char*)g.Bt + (size_t)cur.pn * tstep + (size_t)cur.kc * K * 2;
    S.a_ready(cur);
    if constexpr (SP2) {
        PG8_STAGE(PG8_SB(0, 0), cB, voffB); PG8_STAGE(PG8_SB(0, 1), cB + hstep, voffB); PG8_STAGE(PG8_SA(0, 0), cA, voffA); PG8_STAGE(PG8_SA(0, 1), cA + hstep, voffA);
        if (wr == 1) PG8_BAR;
        PG8_WAIT_V(2); PG8_BAR;
        PG8_STAGE(PG8_SB(1, 0), cB + kstep, voffB); PG8_STAGE(PG8_SA(1, 0), cA + kstep, voffA); PG8_STAGE(PG8_SB(1, 1), cB + hstep + kstep, voffB);
        PG8_WAIT_V(6); PG8_BAR;
    } else {
        PG8_STAGE(PG8_SB(0, 0), cB, voffB); PG8_STAGE(PG8_SA(0, 0), cA, voffA); PG8_STAGE(PG8_SB(0, 1), cB + hstep, voffB); PG8_STAGE(PG8_SA(0, 1), cA + hstep, voffA);
        if (wr == 1) PG8_BAR;
        PG8_WAIT_V(4); PG8_BAR;
        PG8_STAGE(PG8_SB(1, 0), cB + kstep, voffB); PG8_STAGE(PG8_SA(1, 0), cA + kstep, voffA); PG8_STAGE(PG8_SB(1, 1), cB + hstep + kstep, voffB);
        PG8_WAIT_V(6); PG8_BAR;
    }
    for (;;) {
        const bool has_next = S.next(ui + 1, nxt);
        const char* nA = has_next ? (const char*)g.A + (size_t)nxt.pm * tstep + (size_t)nxt.kc * K * 2 : cA; const char* nB = has_next ? (const char*)g.Bt + (size_t)nxt.pn * tstep + (size_t)nxt.kc * K * 2 : cB;
        for (int t = 0; t < nt; t += 2) {
            const bool last = (t == nt - 2);
            const char* a1 = cA + (size_t)(t + 1) * kstep;
            const char* a2 = last ? nA : cA + (size_t)(t + 2) * kstep; const char* b2 = last ? nB : cB + (size_t)(t + 2) * kstep;
            const char* a3 = a2 + kstep; const char* b3 = b2 + kstep;
            if (last && has_next) S.a_ready(nxt);
            if constexpr (SP2) {
            PG8_LDB(B0, 0, 0); PG8_LDB(B1, 0, 1); PG8_SCHED; PG8_LDA(At, 0, 0); PG8_STAGE(PG8_SA(1, 1), a1 + hstep, voffA);
            PG8_WAIT_V(8); PG8_WAIT_L(0); PG8_BAR; PG8_MMA(0, 0, At, B0); PG8_MMA(0, 1, At, B1); PG8_BAR; PG8_SCHED;
            PG8_LDA(At, 0, 1); PG8_STAGE(PG8_SB(0, 0), b2, voffB); PG8_STAGE(PG8_SB(0, 1), b2 + hstep, voffB); PG8_STAGE(PG8_SA(0, 0), a2, voffA);
            PG8_WAIT_V(8); PG8_WAIT_L(0); PG8_BAR; PG8_MMA(1, 0, At, B0); PG8_MMA(1, 1, At, B1); PG8_BAR; PG8_SCHED;
            PG8_LDB(B0, 1, 0); PG8_LDB(B1, 1, 1); PG8_SCHED; PG8_LDA(At, 1, 0); PG8_STAGE(PG8_SA(0, 1), a2 + hstep, voffA);
            PG8_WAIT_V(8); PG8_WAIT_L(0); PG8_BAR; PG8_MMA(0, 0, At, B0); PG8_MMA(0, 1, At, B1); PG8_BAR; PG8_SCHED;
            PG8_LDA(At, 1, 1); PG8_STAGE(PG8_SB(1, 0), b3, voffB); PG8_STAGE(PG8_SB(1, 1), b3 + hstep, voffB); PG8_STAGE(PG8_SA(1, 0), a3, voffA);
            PG8_WAIT_V(8); PG8_WAIT_L(0); PG8_BAR; PG8_MMA(1, 0, At, B0); PG8_MMA(1, 1, At, B1); PG8_BAR; PG8_SCHED;
            } else {
            PG8_LDB(B0, 0, 0); PG8_SCHED; PG8_LDA(At, 0, 0); PG8_STAGE(PG8_SA(1, 1), a1 + hstep, voffA);
            PG8_WAIT_L(8); PG8_BAR; PG8_WAIT_L(0); PG8_MMA(0, 0, At, B0); PG8_BAR; PG8_SCHED;
            PG8_LDB(B1, 0, 1); PG8_STAGE(PG8_SB(0, 0), b2, voffB);
            PG8_BAR; PG8_WAIT_L(0); PG8_MMA(0, 1, At, B1); PG8_BAR;
            PG8_LDA(At, 0, 1); PG8_STAGE(PG8_SA(0, 0), a2, voffA);
            PG8_BAR; PG8_WAIT_L(0); PG8_MMA(1, 0, At, B0); PG8_BAR; PG8_SCHED;
            PG8_STAGE(PG8_SB(0, 1), b2 + hstep, voffB);
            PG8_WAIT_V(6); PG8_BAR; PG8_MMA(1, 1, At, B1); PG8_BAR;
            PG8_LDB(B0, 1, 0); PG8_SCHED; PG8_LDA(At, 1, 0); PG8_STAGE(PG8_SA(0, 1), a2 + hstep, voffA);
            PG8_WAIT_L(8); PG8_BAR; PG8_WAIT_L(0); PG8_MMA(0, 0, At, B0); PG8_BAR; PG8_SCHED;
            PG8_LDB(B1, 1, 1); PG8_STAGE(PG8_SB(1, 0), b3, voffB);
            PG8_BAR; PG8_WAIT_L(0); PG8_MMA(0, 1, At, B1); PG8_BAR;
            PG8_LDA(At, 1, 1); PG8_STAGE(PG8_SA(1, 0), a3, voffA);
            PG8_BAR; PG8_WAIT_L(0); PG8_MMA(1, 0, At, B0); PG8_BAR; PG8_SCHED;
            PG8_STAGE(PG8_SB(1, 1), b3 + hstep, voffB);
            PG8_WAIT_V(6); PG8_BAR; PG8_MMA(1, 1, At, B1); PG8_BAR;
            }
        }
        if constexpr (ALIGN_EPI) { if (wr == 0) PG8_BAR; }
        if constexpr (!Epi::AFTER_DRAIN) { E(acc, cur, wr, wc, fr, fq); S.done(cur); }
        if (!has_next) break;
#pragma unroll
        for (int a = 0; a < 2; ++a)
#pragma unroll
            for (int b = 0; b < 2; ++b)
#pragma unroll
                for (int m = 0; m < 4; ++m)
#pragma unroll
                    for (int n = 0; n < 2; ++n) acc[a][b][m][n] = (f32x4){0.f, 0.f, 0.f, 0.f};
        cur = nxt; cA = nA; cB = nB; ++ui;
        if constexpr (ALIGN_EPI) { if (wr == 1) PG8_BAR; }
    }
    PG8_WAIT_V(0);
    if constexpr (!ALIGN_EPI) { if (wr == 0) PG8_BAR; }
    PG8_BAR;
    if constexpr (Epi::AFTER_DRAIN) { E.fused(acc, cur, wr, wc, fr, fq, lds, wid, lane); S.done(cur); }
#undef PG8_SA
#undef PG8_SB
#undef PG8_STAGE
#undef PG8_LDA
#undef PG8_LDB
#undef PG8_MMA
#undef PG8_WAIT_V
#undef PG8_WAIT_L
#undef PG8_BAR
#undef PG8_SCHED
}
}

#define LAS __attribute__((address_space(3)))
typedef unsigned short bf16_t;
typedef short bf16x8 __attribute__((ext_vector_type(8)));
typedef float f32x4 __attribute__((ext_vector_type(4)));
typedef float f32x16 __attribute__((ext_vector_type(16)));
typedef unsigned u32x4 __attribute__((ext_vector_type(4)));
typedef unsigned u32x2 __attribute__((ext_vector_type(2)));

constexpr int DM = 1024, TP = 65536, TS = 1024, MT = TP + TS;
constexpr int PAST = 2048, TKS = 2080;
constexpr int LROWS = TP + 32 * TKS;
constexpr int LV = LROWS + 256;
constexpr int NIN = 2816, DFF = 2816, NGU = 5632;
constexpr float EPS = 1e-6f;
constexpr float QSCALE = 0.14724444602590306f;

constexpr unsigned OY = 0, OLP = 68157440, OKP = 84934656, OCP = 87031808, OLS = 87040000, OKS = 87302144, OCS = 87334912;

constexpr size_t MiB = 1u << 20;
constexpr size_t OFF_MOD = 0, OFF_BG = 1 * MiB, OFF_BU = 1 * MiB + 512 * 1024, OFF_SSQQ = 2 * MiB, OFF_SSQKV = 6 * MiB + 512 * 1024, OFF_SSQ1 = 8 * MiB, OFF_SSQ2 = 13 * MiB;
constexpr size_t OFF_WIN = 18 * MiB, OFF_WUQ = 24 * MiB, OFF_WKN = 26 * MiB, OFF_WV = 27 * MiB, OFF_WOUT = 28 * MiB, OFF_WGU = 30 * MiB, OFF_WDN = 41 * MiB;
constexpr size_t OFF_CQ = 48 * MiB, OFF_LAT = 146 * MiB, OFF_GI = 211 * MiB, OFF_GB = 276 * MiB, OFF_KRB = 341 * MiB, OFF_A2 = 48 * MiB;
constexpr size_t OFF_QN = 350 * MiB, OFF_QR = 415 * MiB, OFF_KN = 448 * MiB, OFF_VT = 577 * MiB, OFF_MIX = 707 * MiB, OFF_H1 = 448 * MiB, OFF_HFF = 350 * MiB;
constexpr size_t OFF_BAR = 1000 * 1024;
constexpr size_t WS_NEED = 838 * MiB;

constexpr int LDS_BYTES = 147456;

struct Params {
    const float *x_p, *x_s, *c_p, *c_s, *cache_lat, *cache_kr, *state_conv;
    const float *w_ada, *b_ada, *norm_mix_g, *w_in, *q_norm_g, *w_uq, *kv_norm_g, *w_ukv, *conv_w, *conv_b, *w_out, *norm_ffn_g, *w_gate, *w_up, *w_down, *final_g;
    float* out; unsigned char* ws;
};

struct Ctx {
    Params p;
    __device__ __forceinline__ float* mod() const { return (float*)(p.ws + OFF_MOD); }
    __device__ __forceinline__ float* bg() const { return (float*)(p.ws + OFF_BG); }
    __device__ __forceinline__ float* bu() const { return (float*)(p.ws + OFF_BU); }
    __device__ __forceinline__ float* ssq_q() const { return (float*)(p.ws + OFF_SSQQ); }
    __device__ __forceinline__ float* ssq_kv() const { return (float*)(p.ws + OFF_SSQKV); }
    __device__ __forceinline__ float* ssq_x1() const { return (float*)(p.ws + OFF_SSQ1); }
    __device__ __forceinline__ float* ssq_x2() const { return (float*)(p.ws + OFF_SSQ2); }
    __device__ __forceinline__ bf16_t* Win() const { return (bf16_t*)(p.ws + OFF_WIN); }
    __device__ __forceinline__ bf16_t* Wuq() const { return (bf16_t*)(p.ws + OFF_WUQ); }
    __device__ __forceinline__ bf16_t* Wkn() const { return (bf16_t*)(p.ws + OFF_WKN); }
    __device__ __forceinline__ bf16_t* Wv() const { return (bf16_t*)(p.ws + OFF_WV); }
    __device__ __forceinline__ bf16_t* Wout() const { return (bf16_t*)(p.ws + OFF_WOUT); }
    __device__ __forceinline__ bf16_t* Wgu() const { return (bf16_t*)(p.ws + OFF_WGU); }
    __device__ __forceinline__ bf16_t* Wdn() const { return (bf16_t*)(p.ws + OFF_WDN); }
    __device__ __forceinline__ bf16_t* cq() const { return (bf16_t*)(p.ws + OFF_CQ); }
    __device__ __forceinline__ bf16_t* lat() const { return (bf16_t*)(p.ws + OFF_LAT); }
    __device__ __forceinline__ bf16_t* gi() const { return (bf16_t*)(p.ws + OFF_GI); }
    __device__ __forceinline__ bf16_t* gb() const { return (bf16_t*)(p.ws + OFF_GB); }
    __device__ __forceinline__ bf16_t* krb() const { return (bf16_t*)(p.ws + OFF_KRB); }
    __device__ __forceinline__ bf16_t* A2() const { return (bf16_t*)(p.ws + OFF_A2); }
    __device__ __forceinline__ float* part() const { return (float*)(p.ws + OFF_A2); }
    __device__ __forceinline__ bf16_t* xb() const { return (bf16_t*)(p.ws + OFF_GI); }
    __device__ __forceinline__ bf16_t* Qn() const { return (bf16_t*)(p.ws + OFF_QN); }
    __device__ __forceinline__ bf16_t* Qr() const { return (bf16_t*)(p.ws + OFF_QR); }
    __device__ __forceinline__ bf16_t* Kn() const { return (bf16_t*)(p.ws + OFF_KN); }
    __device__ __forceinline__ bf16_t* Vt() const { return (bf16_t*)(p.ws + OFF_VT); }
    __device__ __forceinline__ bf16_t* mix() const { return (bf16_t*)(p.ws + OFF_MIX); }
    __device__ __forceinline__ bf16_t* h1() const { return (bf16_t*)(p.ws + OFF_H1); }
    __device__ __forceinline__ bf16_t* hff() const { return (bf16_t*)(p.ws + OFF_HFF); }
};

__device__ const double ROPE_R[16] = {
    0.15915494309189535, 0.089499401608891013, 0.050329212104487035, 0.028302195830623399, 0.015915494309189534, 0.0089499401608891024, 0.0050329212104487037, 0.0028302195830623399,
    0.0015915494309189536, 0.00089499401608891024, 0.00050329212104487033, 0.00028302195830623395, 0.00015915494309189535, 8.9499401608891018e-05, 5.0329212104487035e-05, 2.8302195830623396e-05};

__device__ __forceinline__ unsigned pk2(float lo, float hi) { return pg8::cvt_pk_bf16(lo, hi); }
__device__ __forceinline__ void st_bf16x8(bf16_t* p, f32x4 a, f32x4 b) { u32x4 w; w.x = pk2(a[0], a[1]); w.y = pk2(a[2], a[3]); w.z = pk2(b[0], b[1]); w.w = pk2(b[2], b[3]); *(u32x4*)p = w; }
__device__ __forceinline__ void ld_bf16x8(const bf16_t* p, f32x4& a, f32x4& b) { const u32x4 w = *(const u32x4*)p;
    a = (f32x4){__uint_as_float(w.x << 16), __uint_as_float(w.x & 0xffff0000u), __uint_as_float(w.y << 16), __uint_as_float(w.y & 0xffff0000u)};
    b = (f32x4){__uint_as_float(w.z << 16), __uint_as_float(w.z & 0xffff0000u), __uint_as_float(w.w << 16), __uint_as_float(w.w & 0xffff0000u)}; }
__device__ __forceinline__ float dot4(f32x4 a) { return (a[0] * a[0] + a[1] * a[1]) + (a[2] * a[2] + a[3] * a[3]); }
__device__ __forceinline__ float sum4(f32x4 a) { return (a[0] + a[1]) + (a[2] + a[3]); }
__device__ __forceinline__ int batch_of(int row) { return row < TP ? (row >> 13) : 8 + ((row - TP) >> 5); }
__device__ __forceinline__ int pos_of(int row) { return row < TP ? (row & 8191) : PAST + ((row - TP) & 31); }
__device__ __forceinline__ int latrow_of(int row) { return row < TP ? row : TP + ((row - TP) >> 5) * TKS + PAST + ((row - TP) & 31); }
__device__ __forceinline__ void rope_cs(int pos, int i, float& c, float& s) {
    double t = (double)pos * ROPE_R[i]; t -= floor(t); const float tf = (float)t;
    c = __builtin_amdgcn_cosf(tf); s = __builtin_amdgcn_sinf(tf);
}
__device__ __forceinline__ float silu_f(float x) { return x * __builtin_amdgcn_rcpf(1.0f + __builtin_amdgcn_exp2f(-1.4426950408889634f * x)); }
__device__ __forceinline__ float rs_of_latrow(const Ctx& C, int L) {
    int tok;
    if (L < TP) tok = L;
    else { const int s = L - TP, b = s / TKS, t = s - b * TKS; if (t < PAST) return 1.0f; tok = TP + b * 32 + (t - PAST); }
    const f32x4 v = *(const f32x4*)(C.ssq_kv() + (unsigned)tok * 4);
    return rsqrtf(sum4(v) * (1.0f / 256.0f) + EPS);
}


__device__ __forceinline__ void row_stats8(const float* part, int row0, int fq, float inv_n, float (&rs)[8]) {
    f32x4 sp[8];
#pragma unroll
    for (int i = 0; i < 8; ++i) sp[i] = *(const f32x4*)(part + (unsigned)(row0 + (i >> 2) * 128 + (i & 3) * 16) * 16 + fq * 4);
#pragma unroll
    for (int i = 0; i < 8; ++i) { float s = sum4(sp[i]); s += __shfl_xor(s, 16); s += __shfl_xor(s, 32); rs[i] = rsqrtf(s * inv_n + EPS); }
}

struct EpiAll {
    static constexpr bool PERM = true, AFTER_DRAIN = false;
    const Ctx& C; int mode;
    __device__ __forceinline__ void operator()(const f32x4 (&acc)[2][2][4][2], const pg8::Unit& u, int wr_, int wc_, int fr_, int fq_) const {
        int wr = wr_, wc = wc_, fr = fr_, fq = fq_;
        asm volatile("" : "+s"(wr), "+s"(wc), "+v"(fr), "+v"(fq));
        const int row0 = u.pm * 256 + wr * 64 + fr, colw = wc * 32 + fq * 8, pn = u.pn;
        if (mode == 0) {
            if (pn < 4) {
                const bool isq = pn < 3;
                const float* gsrc = isq ? C.p.q_norm_g + pn * 256 : C.p.kv_norm_g;
                f32x4 g[2][2];
#pragma unroll
                for (int bj = 0; bj < 2; ++bj)
#pragma unroll
                    for (int n = 0; n < 2; ++n) g[bj][n] = *(const f32x4*)(gsrc + bj * 128 + colw + n * 4);
#pragma unroll
                for (int ai = 0; ai < 2; ++ai)
#pragma unroll
                    for (int m = 0; m < 4; ++m) {
                        const int row = row0 + ai * 128 + m * 16; float s = 0.f;
#pragma unroll
                        for (int bj = 0; bj < 2; ++bj) {
                            const f32x4 v0 = acc[ai][bj][m][0], v1 = acc[ai][bj][m][1]; s += dot4(v0) + dot4(v1);
                            bf16_t* dst;
                            if (isq) dst = C.cq() + (unsigned)row * 768 + pn * 256 + bj * 128 + colw;
                            else {
                                dst = C.lat() + (unsigned)latrow_of(row) * 256 + bj * 128 + colw;
                            }
                            st_bf16x8(dst, v0 * g[bj][0], v1 * g[bj][1]);
                        }
                        s += __shfl_xor(s, 16); s += __shfl_xor(s, 32);
                        if (fq == 0) { if (isq) { C.ssq_q()[(unsigned)row * 16 + pn * 4 + wc] = s; if (pn == 0) C.ssq_q()[(unsigned)row * 16 + 12 + wc] = 0.f; } else C.ssq_kv()[(unsigned)row * 4 + wc] = s; }
                    }
            } else if (pn < 8) {
                const int col = (pn - 4) * 128 + colw;
#pragma unroll
                for (int ai = 0; ai < 2; ++ai)
#pragma unroll
                    for (int m = 0; m < 4; ++m) {
                        const int row = row0 + ai * 128 + m * 16;
                        const f32x4 g0 = acc[ai][0][m][0] * acc[ai][1][m][0], g1 = acc[ai][0][m][1] * acc[ai][1][m][1];
                        st_bf16x8(C.gi() + (unsigned)row * 512 + col, g0, g1);
                        if (row < TP) { const int tt = row & 8191; if (tt >= 8190) { float* o = C.p.out + OCP + (unsigned)((row >> 13) * 2 + (tt - 8190)) * 512 + col; *(f32x4*)o = g0; *(f32x4*)(o + 4) = g1; } }
                        else { const int s = row - TP, tt = s & 31; if (tt >= 30) { float* o = C.p.out + OCS + (unsigned)((s >> 5) * 2 + (tt - 30)) * 512 + col; *(f32x4*)o = g0; *(f32x4*)(o + 4) = g1; } }
                    }
            } else if (pn < 10) {
#pragma unroll
                for (int ai = 0; ai < 2; ++ai)
#pragma unroll
                    for (int m = 0; m < 4; ++m) {
                        const int row = row0 + ai * 128 + m * 16;
#pragma unroll
                        for (int bj = 0; bj < 2; ++bj) st_bf16x8(C.gb() + (unsigned)row * 512 + (pn - 8) * 256 + bj * 128 + colw, acc[ai][bj][m][0], acc[ai][bj][m][1]);
                    }
            } else {
                if (wc == 0 && fq < 2) {
#pragma unroll
                    for (int ai = 0; ai < 2; ++ai)
#pragma unroll
                        for (int m = 0; m < 4; ++m) {
                            const int row = row0 + ai * 128 + m * 16, pos = pos_of(row);
                            f32x4 y1[2], y2[2];
#pragma unroll
                            for (int n = 0; n < 2; ++n)
#pragma unroll
                                for (int e = 0; e < 4; ++e) {
                                    float c, s; rope_cs(pos, fq * 8 + n * 4 + e, c, s);
                                    const float x1 = acc[ai][0][m][n][e], x2 = acc[ai][1][m][n][e];
                                    y1[n][e] = x1 * c - x2 * s; y2[n][e] = x1 * s + x2 * c;
                                }
                            float* o = C.p.out + (row < TP ? OKP + (unsigned)row * 32 : OKS + (unsigned)(row - TP) * 32) + fq * 8;
                            *(f32x4*)o = y1[0]; *(f32x4*)(o + 4) = y1[1]; *(f32x4*)(o + 16) = y2[0]; *(f32x4*)(o + 20) = y2[1];
                            bf16_t* kb = C.krb() + (unsigned)latrow_of(row) * 32 + fq * 8;
                            st_bf16x8(kb, y1[0], y1[1]); st_bf16x8(kb + 16, y2[0], y2[1]);
                        }
                }
            }
        } else if (mode == 1) {
            float rqv[8]; row_stats8(C.ssq_q(), row0, fq, 1.0f / 768.0f, rqv);
#pragma unroll
            for (int ai = 0; ai < 2; ++ai)
#pragma unroll
                for (int m = 0; m < 4; ++m) {
                    const int row = row0 + ai * 128 + m * 16;
                    const float rq = rqv[ai * 4 + m] * QSCALE;
                    if (pn < 2) {
#pragma unroll
                        for (int bj = 0; bj < 2; ++bj) st_bf16x8(C.Qn() + (unsigned)row * 512 + pn * 256 + bj * 128 + colw, acc[ai][bj][m][0] * rq, acc[ai][bj][m][1] * rq);
                    } else {
                        const int pos = pos_of(row), sel = fq & 1;
                        f32x4 y1[2], y2[2];
#pragma unroll
                        for (int n = 0; n < 2; ++n)
#pragma unroll
                            for (int e = 0; e < 4; ++e) {
                                float c, s; rope_cs(pos, sel * 8 + n * 4 + e, c, s);
                                const float x1 = acc[ai][0][m][n][e] * rq, x2 = acc[ai][1][m][n][e] * rq;
                                y1[n][e] = x1 * c - x2 * s; y2[n][e] = x1 * s + x2 * c;
                            }
                        bf16_t* q = C.Qr() + (unsigned)row * 256 + colw;
                        st_bf16x8(q, y1[0], y1[1]); st_bf16x8(q + 128, y2[0], y2[1]);
                    }
                }
        } else if (mode == 2) {
            f32x4 sv[8]; bool past[8];
#pragma unroll
            for (int i = 0; i < 8; ++i) {
                const int L = row0 + (i >> 2) * 128 + (i & 3) * 16; int tok = L; past[i] = false;
                if (L >= TP) { const int s = L - TP, bb = s / TKS, t = s - bb * TKS; past[i] = t < PAST; tok = past[i] ? 0 : TP + bb * 32 + (t - PAST); }
                sv[i] = *(const f32x4*)(C.ssq_kv() + (unsigned)tok * 4);
            }
#pragma unroll
            for (int ai = 0; ai < 2; ++ai)
#pragma unroll
                for (int m = 0; m < 4; ++m) {
                    const int row = row0 + ai * 128 + m * 16, i = ai * 4 + m;
                    const float rs = past[i] ? 1.0f : rsqrtf(sum4(sv[i]) * (1.0f / 256.0f) + EPS);
#pragma unroll
                    for (int bj = 0; bj < 2; ++bj) st_bf16x8(C.Kn() + (unsigned)row * 512 + pn * 256 + bj * 128 + colw, acc[ai][bj][m][0] * rs, acc[ai][bj][m][1] * rs);
                }
        } else if (mode == 3) {
            f32x4 rs[2][2];
#pragma unroll
            for (int bj = 0; bj < 2; ++bj) {
                f32x4 sv[8]; bool past[8];
#pragma unroll
                for (int i = 0; i < 8; ++i) {
                    const int L = pn * 256 + bj * 128 + colw + i; int tok = L; past[i] = false;
                    if (L >= TP) { const int s = L - TP, bb = s / TKS, t = s - bb * TKS; past[i] = t < PAST; tok = past[i] ? 0 : TP + bb * 32 + (t - PAST); }
                    sv[i] = *(const f32x4*)(C.ssq_kv() + (unsigned)tok * 4);
                }
#pragma unroll
                for (int i = 0; i < 8; ++i) rs[bj][i >> 2][i & 3] = past[i] ? 1.0f : rsqrtf(sum4(sv[i]) * (1.0f / 256.0f) + EPS);
            }
#pragma unroll
            for (int ai = 0; ai < 2; ++ai)
#pragma unroll
                for (int m = 0; m < 4; ++m) {
                    const int row = row0 + ai * 128 + m * 16;
#pragma unroll
                    for (int bj = 0; bj < 2; ++bj) st_bf16x8(C.Vt() + (unsigned)row * LV + pn * 256 + bj * 128 + colw, acc[ai][bj][m][0] * rs[bj][0], acc[ai][bj][m][1] * rs[bj][1]);
                }
        } else if (mode == 4) {
            if (u.pm * 256 < TP) {
                const float* mb = C.mod() + (unsigned)(u.pm >> 5) * 6144;
                f32x4 g1h[2][2], gkh[2][2];
#pragma unroll
                for (int bj = 0; bj < 2; ++bj)
#pragma unroll
                    for (int n = 0; n < 2; ++n) { const int c4 = pn * 256 + bj * 128 + colw + n * 4;
                        g1h[bj][n] = *(const f32x4*)(mb + 2048 + c4); gkh[bj][n] = *(const f32x4*)(C.p.norm_ffn_g + c4) * (*(const f32x4*)(mb + 4096 + c4) + 1.0f); }
#pragma unroll
                for (int ai = 0; ai < 2; ++ai)
#pragma unroll
                    for (int mp = 0; mp < 2; ++mp) {
                        f32x4 xv[2][2][2];
#pragma unroll
                        for (int mm = 0; mm < 2; ++mm) { const float* xr = C.p.x_p + (unsigned)(row0 + ai * 128 + (mp * 2 + mm) * 16) * DM + pn * 256 + colw;
#pragma unroll
                            for (int bj = 0; bj < 2; ++bj) { xv[mm][bj][0] = *(const f32x4*)(xr + bj * 128); xv[mm][bj][1] = *(const f32x4*)(xr + bj * 128 + 4); } }
#pragma unroll
                        for (int mm = 0; mm < 2; ++mm) { const int m = mp * 2 + mm, row = row0 + ai * 128 + m * 16; float s = 0.f;
#pragma unroll
                            for (int bj = 0; bj < 2; ++bj) { const int col = pn * 256 + bj * 128 + colw;
                                const f32x4 xa = xv[mm][bj][0] + g1h[bj][0] * acc[ai][bj][m][0], xb = xv[mm][bj][1] + g1h[bj][1] * acc[ai][bj][m][1];
                                st_bf16x8(C.xb() + (unsigned)row * DM + col, xa, xb); s += dot4(xa) + dot4(xb);
                                st_bf16x8(C.A2() + (unsigned)row * DM + col, xa * gkh[bj][0], xb * gkh[bj][1]); }
                            s += __shfl_xor(s, 16); s += __shfl_xor(s, 32);
                            if (fq == 0) C.ssq_x1()[(unsigned)row * 16 + pn * 4 + wc] = s; }
                        asm volatile("" ::: "memory");
                    }
            } else {
#pragma unroll
            for (int ai = 0; ai < 2; ++ai)
#pragma unroll
                for (int m = 0; m < 4; ++m) {
                    const int row = row0 + ai * 128 + m * 16, b = batch_of(row);
                    const float* xr = row < TP ? C.p.x_p + (unsigned)row * DM : C.p.x_s + (unsigned)(row - TP) * DM;
                    const float* mb = C.mod() + (unsigned)b * 6144; float s = 0.f;
#pragma unroll
                    for (int bj = 0; bj < 2; ++bj) {
                        const int col = pn * 256 + bj * 128 + colw; f32x4 a2[2], xk[2];
#pragma unroll
                        for (int n = 0; n < 2; ++n) {
                            const int c4 = col + n * 4;
                            const f32x4 xv = *(const f32x4*)(xr + c4), g1 = *(const f32x4*)(mb + 2048 + c4), sc2 = *(const f32x4*)(mb + 4096 + c4), gn = *(const f32x4*)(C.p.norm_ffn_g + c4);
                            const f32x4 x1 = xv + g1 * acc[ai][bj][m][n];
                            xk[n] = x1; s += dot4(x1);
                            a2[n] = x1 * gn * (sc2 + 1.0f);
                        }
                        st_bf16x8(C.xb() + (unsigned)row * DM + col, xk[0], xk[1]);
                        st_bf16x8(C.A2() + (unsigned)row * DM + col, a2[0], a2[1]);
                    }
                    s += __shfl_xor(s, 16); s += __shfl_xor(s, 32);
                    if (fq == 0) C.ssq_x1()[(unsigned)row * 16 + pn * 4 + wc] = s;
                }
            }
        } else if (mode == 5) {
            const int colg = pn * 128 + colw;
            float rsv[8]; row_stats8(C.ssq_x1(), row0, fq, 1.0f / 1024.0f, rsv);
            if (u.pm * 256 < TP) {
                f32x4 bgh[2], buh[2];
                { const size_t bo = (unsigned)(u.pm >> 5) * DFF + colg;
#pragma unroll
                  for (int n = 0; n < 2; ++n) { bgh[n] = *(const f32x4*)(C.bg() + bo + n * 4); buh[n] = *(const f32x4*)(C.bu() + bo + n * 4); } }
#pragma unroll
                for (int ai = 0; ai < 2; ++ai)
#pragma unroll
                    for (int m = 0; m < 4; ++m) {
                        const int row = row0 + ai * 128 + m * 16; const float rstd = rsv[ai * 4 + m]; f32x4 hv[2];
#pragma unroll
                        for (int n = 0; n < 2; ++n) {
                            const f32x4 gate = acc[ai][0][m][n] * rstd + bgh[n], up = acc[ai][1][m][n] * rstd + buh[n];
#pragma unroll
                            for (int e = 0; e < 4; ++e) hv[n][e] = silu_f(gate[e]) * up[e];
                        }
                        st_bf16x8(C.hff() + (unsigned)row * DFF + colg, hv[0], hv[1]);
                    }
            } else {
#pragma unroll
                for (int ai = 0; ai < 2; ++ai)
#pragma unroll
                    for (int m = 0; m < 4; ++m) {
                        const int row = row0 + ai * 128 + m * 16; const float rstd = rsv[ai * 4 + m]; f32x4 hv[2];
                        const size_t bo = (unsigned)batch_of(row) * DFF + colg;
#pragma unroll
                        for (int n = 0; n < 2; ++n) {
                            const f32x4 gate = acc[ai][0][m][n] * rstd + *(const f32x4*)(C.bg() + bo + n * 4), up = acc[ai][1][m][n] * rstd + *(const f32x4*)(C.bu() + bo + n * 4);
#pragma unroll
                            for (int e = 0; e < 4; ++e) hv[n][e] = silu_f(gate[e]) * up[e];
                        }
                        st_bf16x8(C.hff() + (unsigned)row * DFF + colg, hv[0], hv[1]);
                    }
            }
        } else if (mode == 6) {
            if (u.pm * 256 < TP) {
                const float* mb = C.mod() + (unsigned)(u.pm >> 5) * 6144 + 5120 + pn * 256 + colw;
                const f32x4 g2a0 = *(const f32x4*)mb, g2b0 = *(const f32x4*)(mb + 4), g2a1 = *(const f32x4*)(mb + 128), g2b1 = *(const f32x4*)(mb + 132);
#pragma unroll
                for (int ai = 0; ai < 2; ++ai) {
                    u32x4 xw[4][2];
#pragma unroll
                    for (int m = 0; m < 4; ++m) { const bf16_t* xr = C.xb() + (unsigned)(row0 + ai * 128 + m * 16) * DM + pn * 256 + colw; xw[m][0] = *(const u32x4*)xr; xw[m][1] = *(const u32x4*)(xr + 128); }
#pragma unroll
                    for (int m = 0; m < 4; ++m) { bf16_t* xr = C.xb() + (unsigned)(row0 + ai * 128 + m * 16) * DM + pn * 256 + colw;
#pragma unroll
                        for (int bj = 0; bj < 2; ++bj) { const u32x4 w = xw[m][bj];
                            const f32x4 xa = (f32x4){__uint_as_float(w.x << 16), __uint_as_float(w.x & 0xffff0000u), __uint_as_float(w.y << 16), __uint_as_float(w.y & 0xffff0000u)};
                            const f32x4 xc = (f32x4){__uint_as_float(w.z << 16), __uint_as_float(w.z & 0xffff0000u), __uint_as_float(w.w << 16), __uint_as_float(w.w & 0xffff0000u)};
                            st_bf16x8(xr + bj * 128, xa + (bj ? g2a1 : g2a0) * acc[ai][bj][m][0], xc + (bj ? g2b1 : g2b0) * acc[ai][bj][m][1]); } }
                    asm volatile("" ::: "memory");
                }
            } else {
#pragma unroll
                for (int ai = 0; ai < 2; ++ai)
#pragma unroll
                    for (int m = 0; m < 4; ++m) {
                        const int row = row0 + ai * 128 + m * 16;
                        const float* mb = C.mod() + (unsigned)batch_of(row) * 6144 + 5120;
#pragma unroll
                        for (int bj = 0; bj < 2; ++bj) {
                            const int col = pn * 256 + bj * 128 + colw; bf16_t* xr = C.xb() + (unsigned)row * DM + col;
                            f32x4 xa, xc; ld_bf16x8(xr, xa, xc);
                            st_bf16x8(xr, xa + *(const f32x4*)(mb + col) * acc[ai][bj][m][0], xc + *(const f32x4*)(mb + col + 4) * acc[ai][bj][m][1]);
                        }
                    }
            }
        } else if (mode == 7) {
#pragma unroll
            for (int ai = 0; ai < 2; ++ai)
#pragma unroll
                for (int m = 0; m < 4; ++m) {
                    float* o = C.part() + ((unsigned)u.kc * 1024 + (unsigned)(row0 + ai * 128 + m * 16)) * 1024 + pn * 256 + colw;
#pragma unroll
                    for (int bj = 0; bj < 2; ++bj) { *(f32x4*)(o + bj * 128) = acc[ai][bj][m][0]; *(f32x4*)(o + bj * 128 + 4) = acc[ai][bj][m][1]; }
                }
        }
    }
};

struct WSrc { const float* W; int ld; int col; };
__device__ __forceinline__ WSrc wsrc(const Ctx& C, int mat, int n) {
    WSrc r; r.W = C.p.w_in; r.ld = 2592; r.col = -1;
    if (mat == 0) {
        if (n < 1024) r.col = n;
        else if (n < 2048) { const int j = (n - 1024) >> 8, c = (n - 1024) & 255; r.col = c < 128 ? 1056 + 128 * j + c : 2080 + 128 * j + (c - 128); }
        else if (n < 2560) r.col = 1568 + (n - 2048);
        else { const int c = n - 2560; if (c < 16) r.col = 1024 + c; else if (c >= 128 && c < 144) r.col = 1040 + (c - 128); }
    } else if (mat == 1) {
        r.W = C.p.w_uq; r.ld = 768;
        if (n < 512) r.col = (n >> 6) * 96 + (n & 63);
        else { const int c = n - 512, half = c >> 7, cc = c & 127; r.col = (cc >> 4) * 96 + 64 + half * 16 + (cc & 15); }
    } else if (mat == 2) { r.W = C.p.w_ukv; r.ld = 1024; r.col = (n >> 6) * 128 + (n & 63); }
    else if (mat == 3) { r.W = C.p.w_ukv; r.ld = 1024; r.col = (n >> 6) * 128 + 64 + (n & 63); }
    else if (mat == 4) { r.W = C.p.w_out; r.ld = 1024; r.col = n; }
    else if (mat == 5) { const int j = n >> 8, c = n & 255; r.ld = 2816; if (c < 128) { r.W = C.p.w_gate; r.col = 128 * j + c; } else { r.W = C.p.w_up; r.col = 128 * j + (c - 128); } }
    else { r.W = C.p.w_down; r.ld = 1024; r.col = n; }
    return r;
}
__device__ __forceinline__ void transpose_item(const Ctx& C, int mat, int K, bf16_t* WT, LAS float* scr, int item, int nblk, int lane_) {
    int lane = lane_; asm volatile("" : "+v"(lane));
    const int kb = item / nblk, nb = item - kb * nblk, k0 = 64 * kb, n0 = 32 * nb;
    const WSrc s = wsrc(C, mat, n0 + (lane & 31));
    float tv[32];
#pragma unroll
    for (int i = 0; i < 32; ++i) { const int kk = 2 * i + (lane >> 5); tv[i] = s.col >= 0 ? s.W[(size_t)(k0 + kk) * s.ld + s.col] : 0.f; }
#pragma unroll
    for (int i = 0; i < 32; ++i) { const int kk = 2 * i + (lane >> 5); scr[kk * 33 + (lane & 31)] = tv[i]; }
    asm volatile("s_waitcnt lgkmcnt(0)" ::: "memory");
    const int c = lane & 7;
#pragma unroll
    for (int j = 0; j < 4; ++j) { const int n = (lane >> 3) + 8 * j; const LAS float* t = scr + (8 * c) * 33 + n;
        u32x4 o; o.x = pk2(t[0 * 33], t[1 * 33]); o.y = pk2(t[2 * 33], t[3 * 33]); o.z = pk2(t[4 * 33], t[5 * 33]); o.w = pk2(t[6 * 33], t[7 * 33]);
        *(u32x4*)(WT + (size_t)(n0 + n) * K + k0 + 8 * c) = o; }
    asm volatile("s_waitcnt lgkmcnt(0)" ::: "memory");
}

template <int ACT>
__device__ __forceinline__ void gemv_item(const Ctx& C, LAS unsigned char* lds, const float* W, int ldw, int n0, const float* bias, float* outp, int ldo, int tid_, int wave, int lane_) {
    int tid = tid_, lane = lane_; asm volatile("" : "+v"(tid), "+v"(lane));
    LAS float* act = (LAS float*)lds + wave * 2560;
    float acc[40];
#pragma unroll
    for (int b = 0; b < 40; ++b) acc[b] = 0.f;
    for (int pass = 0; pass < 2; ++pass) {
        const int kbase = wave * 128 + pass * 64;
        {
            const int k = kbase + lane; float av[40];
#pragma unroll
            for (int bb = 0; bb < 40; ++bb) av[bb] = ACT == 0 ? (bb < 8 ? C.p.c_p[bb * 1024 + k] : C.p.c_s[(bb - 8) * 1024 + k]) : C.mod()[(size_t)bb * 6144 + 3072 + k];
#pragma unroll
            for (int bb = 0; bb < 40; ++bb) { float v = av[bb]; if (ACT == 0) v = v / (1.0f + __expf(-v)); act[lane * 40 + bb] = v; }
        }
        asm volatile("s_waitcnt lgkmcnt(0)" ::: "memory");
        for (int kq = 0; kq < 64; kq += 16) {
        float wv[16];
#pragma unroll
        for (int i = 0; i < 16; ++i) wv[i] = W[(size_t)(kbase + kq + i) * ldw + n0 + lane];
#pragma unroll
        for (int i = 0; i < 16; ++i) {
            const int kk = kq + i; const float w = wv[i];
#pragma unroll
            for (int b4 = 0; b4 < 10; ++b4) { const f32x4 a = *(const LAS f32x4*)(act + kk * 40 + b4 * 4);
                acc[b4 * 4 + 0] += a[0] * w; acc[b4 * 4 + 1] += a[1] * w; acc[b4 * 4 + 2] += a[2] * w; acc[b4 * 4 + 3] += a[3] * w; }
        }
        }
        asm volatile("s_waitcnt lgkmcnt(0)" ::: "memory");
    }
    __syncthreads();
    LAS float* red = (LAS float*)lds;
#pragma unroll
    for (int b = 0; b < 40; ++b) red[(wave * 40 + b) * 64 + lane] = acc[b];
    __syncthreads();
    for (int o = tid; o < 2560; o += 512) { const int b = o >> 6, l = o & 63; float s = bias ? bias[n0 + l] : 0.f;
#pragma unroll
        for (int w = 0; w < 8; ++w) s += red[(w * 40 + b) * 64 + l];
        outp[(size_t)b * ldo + n0 + l] = s; }
    __syncthreads();
}

constexpr int KSTR = 208, VSTR = 144, KBYTES = 64 * KSTR, VBYTES = 64 * VSTR, ATB = KBYTES + VBYTES;
#define ATT_THR 40.0f
__device__ __forceinline__ bf16x8 pack8(const f32x16& p, int b) {
    u32x4 w; w.x = pk2(p[b], p[b + 1]); w.y = pk2(p[b + 2], p[b + 3]); w.z = pk2(p[b + 4], p[b + 5]); w.w = pk2(p[b + 6], p[b + 7]); return __builtin_bit_cast(bf16x8, w);
}
__device__ __forceinline__ float xmax32(float x) {
    auto rr = __builtin_amdgcn_permlane32_swap(__float_as_uint(x), __float_as_uint(x), false, false);
    return fmaxf(__uint_as_float(rr[0]), __uint_as_float(rr[1]));
}
__device__ __forceinline__ float xsum32(float x) {
    auto rr = __builtin_amdgcn_permlane32_swap(__float_as_uint(x), __float_as_uint(x), false, false);
    return __uint_as_float(rr[0]) + __uint_as_float(rr[1]);
}
#define ASB() __builtin_amdgcn_sched_barrier(0)
#if defined(PROBE_NOBAR)
#define ATT_BAR() do { if (!nomem) __syncthreads(); } while (0)
#else
#define ATT_BAR() __syncthreads()
#endif
__device__ __forceinline__ float max3f(float a, float b, float c) { float r; asm("v_max3_f32 %0, %1, %2, %3" : "=v"(r) : "v"(a), "v"(b), "v"(c)); return r; }
__device__ __forceinline__ void attn_unit(const Ctx& C, LAS unsigned char* lds, int kvbase, int NT, int wlim, bool half_last, int qrow, int h, int tid, int lane, bool nomem) {
    const int i32 = lane & 31, hi = lane >> 5;
    const int pi = (((i32 >> 2) & 1) << 4) | ((i32 >> 3) << 2) | (i32 & 3);
    const bool active = wlim >= 0;
    bf16x8 qf[6];
#pragma unroll
    for (int kb = 0; kb < 6; ++kb) qf[kb] = (bf16x8){0, 0, 0, 0, 0, 0, 0, 0};
    if (active) {
        const bf16_t* qn = C.Qn() + (size_t)qrow * 512 + h * 64 + hi * 8;
#pragma unroll
        for (int kb = 0; kb < 4; ++kb) qf[kb] = *(const bf16x8*)(qn + kb * 16);
        const bf16_t* qr = C.Qr() + (size_t)qrow * 256 + h * 16 + hi * 8;
        qf[4] = *(const bf16x8*)qr; qf[5] = *(const bf16x8*)(qr + 128);
    }
    f32x16 o0, o1, oL;
#pragma unroll
    for (int r = 0; r < 16; ++r) { o0[r] = 0.f; o1[r] = 0.f; oL[r] = 0.f; }
    float mref = 0.f, lrun = 0.f; bool shifted = false;
    const bf16x8 ones = (bf16x8){0x3F80, 0x3F80, 0x3F80, 0x3F80, 0x3F80, 0x3F80, 0x3F80, 0x3F80};
    const int sr = tid >> 3, sc = tid & 7;
    const bf16_t* gKn = C.Kn() + (size_t)(kvbase + sr) * 512 + h * 64 + sc * 8;
    const bf16_t* gKr = C.krb() + (size_t)(kvbase + (tid >> 2)) * 32 + (tid & 3) * 8;
    const bf16_t* gV = C.Vt() + (size_t)(h * 64 + sr) * LV + kvbase + sc * 8;
    const unsigned dK = sr * KSTR + sc * 16, dKr = (tid >> 2) * KSTR + 128 + (tid & 3) * 16, dV = KBYTES + sr * VSTR + sc * 16;
    const bool do_kr = tid < 256;
    u32x4 rk, rkr = (u32x4){0, 0, 0, 0}, rv;
#define ATT_LOAD(j) do { rk = *(const u32x4*)(gKn + (size_t)(j) * 64 * 512); if (do_kr) rkr = *(const u32x4*)(gKr + (size_t)(j) * 64 * 32); rv = *(const u32x4*)(gV + (size_t)(j) * 64); } while (0)
#define ATT_STORE(slot) do { LAS unsigned char* bb_ = lds + (slot) * ATB; *(LAS u32x4*)(bb_ + dK) = rk; if (do_kr) *(LAS u32x4*)(bb_ + dKr) = rkr; *(LAS u32x4*)(bb_ + dV) = rv; } while (0)
    ATT_LOAD(0); ATT_STORE(0);
    if (NT > 1) { ATT_LOAD(1); ATT_STORE(1); }
    __syncthreads();
    const unsigned kfo = pi * KSTR + hi * 16, vfo = KBYTES + pi * VSTR + hi * 32;
    f32x16 sA0, sA1, sB0, sB1;
    bf16x8 pb[4];
#pragma unroll
    for (int c = 0; c < 4; ++c) pb[c] = (bf16x8){0, 0, 0, 0, 0, 0, 0, 0};
    if (active) {
        const LAS unsigned char* ka = lds + kfo;
#pragma unroll
        for (int kb = 0; kb < 6; ++kb) {
            const bf16x8 k0 = *(const LAS bf16x8*)(ka + kb * 32), k1 = *(const LAS bf16x8*)(ka + 32 * KSTR + kb * 32);
            sA0 = __builtin_amdgcn_mfma_f32_32x32x16_bf16(k0, qf[kb], kb == 0 ? oL : sA0, 0, 0, 0);
            sA1 = __builtin_amdgcn_mfma_f32_32x32x16_bf16(k1, qf[kb], kb == 0 ? oL : sA1, 0, 0, 0);
        }
    }
#define ATT_VF_LO(va) do { vf[0] = *(const LAS bf16x8*)(va); vf[1] = *(const LAS bf16x8*)((va) + 32 * VSTR); vf[2] = *(const LAS bf16x8*)((va) + 16); vf[3] = *(const LAS bf16x8*)((va) + 32 * VSTR + 16); } while (0)
#define ATT_VF_HI(va) do { vf[0] = *(const LAS bf16x8*)((va) + 64); vf[1] = *(const LAS bf16x8*)((va) + 32 * VSTR + 64); vf[2] = *(const LAS bf16x8*)((va) + 80); vf[3] = *(const LAS bf16x8*)((va) + 32 * VSTR + 80); } while (0)
#define ATT_PVMMA(i) do { if ((i) & 1) o1 = __builtin_amdgcn_mfma_f32_32x32x16_bf16(vf[(i) & 3], pb[(i) >> 1], o1, 0, 0, 0); else o0 = __builtin_amdgcn_mfma_f32_32x32x16_bf16(vf[(i) & 3], pb[(i) >> 1], o0, 0, 0, 0); } while (0)
#define ATT_EXP4(SA0, SA1, i) do { if ((i) < 4) { _Pragma("unroll") for (int r = 4 * (i); r < 4 * (i) + 4; ++r) SA0[r] = __builtin_amdgcn_exp2f(SA0[r]); asm volatile("" : "+v"(SA0)); } \
                                   else { _Pragma("unroll") for (int r = 4 * ((i) - 4); r < 4 * ((i) - 4) + 4; ++r) SA1[r] = __builtin_amdgcn_exp2f(SA1[r]); asm volatile("" : "+v"(SA1)); } } while (0)
#define ATT_EXP2(SA0, SA1, j) do { if ((j) < 8) { SA0[2 * (j)] = __builtin_amdgcn_exp2f(SA0[2 * (j)]); SA0[2 * (j) + 1] = __builtin_amdgcn_exp2f(SA0[2 * (j) + 1]); asm volatile("" : "+v"(SA0)); } \
                                   else { SA1[2 * ((j) - 8)] = __builtin_amdgcn_exp2f(SA1[2 * ((j) - 8)]); SA1[2 * ((j) - 8) + 1] = __builtin_amdgcn_exp2f(SA1[2 * ((j) - 8) + 1]); asm volatile("" : "+v"(SA1)); } } while (0)
#define ATT_MAXUPD(SA0, SA1, t_) \
    if (half_last && (t_) == NT - 1) { asm volatile("" ::: "memory"); _Pragma("unroll") for (int r = 0; r < 16; ++r) SA1[r] = -INFINITY; } \
    float mxa = max3f(SA0[0], SA0[1], SA0[2]), mxb = max3f(SA0[4], SA0[5], SA0[6]), mxc = max3f(SA1[0], SA1[1], SA1[2]), mxd = max3f(SA1[4], SA1[5], SA1[6]); \
    mxa = max3f(mxa, SA0[3], SA0[8]); mxb = max3f(mxb, SA0[7], SA0[9]); mxc = max3f(mxc, SA1[3], SA1[8]); mxd = max3f(mxd, SA1[7], SA1[9]); \
    mxa = max3f(mxa, SA0[10], SA0[11]); mxb = max3f(mxb, SA0[12], SA0[13]); mxc = max3f(mxc, SA1[10], SA1[11]); mxd = max3f(mxd, SA1[12], SA1[13]); \
    mxa = max3f(mxa, SA0[14], SA0[15]); mxc = max3f(mxc, SA1[14], SA1[15]); \
    float mx = max3f(mxa, mxb, mxc); mx = fmaxf(mx, mxd); \
    mx = xmax32(mx); \
    const bool upd = __any(mx > ATT_THR || ((t_) == 0 && mx < -ATT_THR)); float alpha = 1.0f; \
    if (upd) { const float delta = (mx > ATT_THR || ((t_) == 0 && mx < -ATT_THR)) ? mx : 0.f; mref += delta; alpha = __builtin_amdgcn_exp2f(-delta); shifted = true; \
        _Pragma("unroll") for (int r = 0; r < 16; ++r) { SA0[r] -= delta; SA1[r] -= delta; } }
#define ATT_QK_SUM(SA0, SA1, SB0, SB1, t_, TAILEXP) do { const LAS unsigned char* ka = lds + (((t_) + 1) & 3) * ATB + kfo; \
      bf16x8 kf[4]; kf[0] = *(const LAS bf16x8*)(ka); kf[1] = *(const LAS bf16x8*)(ka + 32 * KSTR); kf[2] = *(const LAS bf16x8*)(ka + 32); kf[3] = *(const LAS bf16x8*)(ka + 32 * KSTR + 32); \
      _Pragma("unroll") for (int kb = 0; kb < 6; ++kb) { const int s_ = (kb & 1) * 2; \
        if (kb == 0) { if (shifted) { f32x16 cinit; { const float nm = -mref; _Pragma("unroll") for (int r = 0; r < 16; ++r) cinit[r] = nm; } \
                SB0 = __builtin_amdgcn_mfma_f32_32x32x16_bf16(kf[0], qf[0], cinit, 0, 0, 0); SB1 = __builtin_amdgcn_mfma_f32_32x32x16_bf16(kf[1], qf[0], cinit, 0, 0, 0); } \
            else { const f32x16 z16 = {0.f, 0.f, 0.f, 0.f, 0.f, 0.f, 0.f, 0.f, 0.f, 0.f, 0.f, 0.f, 0.f, 0.f, 0.f, 0.f}; \
                SB0 = __builtin_amdgcn_mfma_f32_32x32x16_bf16(kf[0], qf[0], z16, 0, 0, 0); SB1 = __builtin_amdgcn_mfma_f32_32x32x16_bf16(kf[1], qf[0], z16, 0, 0, 0); } \
            if (TAILEXP) { ATT_EXP2(SA0, SA1, 12); ATT_EXP2(SA0, SA1, 13); } } \
        else { SB0 = __builtin_amdgcn_mfma_f32_32x32x16_bf16(kf[s_], qf[kb], SB0, 0, 0, 0); \
               if (TAILEXP && kb == 1) ATT_EXP2(SA0, SA1, 14); \
               SB1 = __builtin_amdgcn_mfma_f32_32x32x16_bf16(kf[s_ + 1], qf[kb], SB1, 0, 0, 0); \
               if (TAILEXP && kb == 1) ATT_EXP2(SA0, SA1, 15); } \
        if (kb + 2 < 6) { kf[s_] = *(const LAS bf16x8*)(ka + (kb + 2) * 32); kf[s_ + 1] = *(const LAS bf16x8*)(ka + 32 * KSTR + (kb + 2) * 32); } \
        if (kb >= 1 && kb < 5) { const int c_ = kb - 1; if (c_ < 2) { pb[c_] = pack8(SA0, (c_ & 1) * 8); _Pragma("unroll") for (int r = (c_ & 1) * 8; r < (c_ & 1) * 8 + 8; ++r) lrun += SA0[r]; } else { pb[c_] = pack8(SA1, (c_ & 1) * 8); _Pragma("unroll") for (int r = (c_ & 1) * 8; r < (c_ & 1) * 8 + 8; ++r) lrun += SA1[r]; } } \
        ASB(); } \
      } while (0)
#define ATT_FIRST(SA0, SA1, SB0, SB1) do { const bool ld2 = 2 < NT && !nomem; if (ld2) ATT_LOAD(2); \
    { ATT_MAXUPD(SA0, SA1, 0) (void)alpha; } \
    _Pragma("unroll") for (int i = 0; i < 8; ++i) ATT_EXP4(SA0, SA1, i); \
    ATT_BAR(); if (ld2) ATT_STORE(2); \
    ATT_QK_SUM(SA0, SA1, SB0, SB1, 0, false); ATT_BAR(); } while (0)
#define ATT_FULL(SA0, SA1, SB0, SB1, t) do { const int t_ = (t); const bool ld2 = t_ + 2 < NT && !nomem; if (ld2) ATT_LOAD(t_ + 2); \
    bf16x8 vf[4]; const LAS unsigned char* va = lds + ((t_ + 3) & 3) * ATB + vfo; ATT_VF_LO(va); \
    ATT_MAXUPD(SA0, SA1, t_) \
    ASB(); \
    _Pragma("unroll") for (int i = 0; i < 8; ++i) { ATT_PVMMA(i); if (i < 4) vf[i] = *(const LAS bf16x8*)((va) + 64 + (i >> 1) * 16 + (i & 1) * 32 * VSTR); ATT_EXP2(SA0, SA1, i + (i >> 1)); ASB(); \
        if (i & 1) { ATT_EXP2(SA0, SA1, i + (i >> 1) + 1); ASB(); } } \
    if (upd) { lrun *= alpha; _Pragma("unroll") for (int r = 0; r < 16; ++r) { o0[r] *= alpha; o1[r] *= alpha; } } \
    ATT_BAR(); if (ld2) ATT_STORE((t_ + 2) & 3); \
    ATT_QK_SUM(SA0, SA1, SB0, SB1, t_, true); ATT_BAR(); } while (0)
#define ATT_LAST(t) do { const int t_ = (t); const bool ld2 = t_ + 2 < NT && !nomem; if (ld2) ATT_LOAD(t_ + 2); \
    bf16x8 vf[4]; const LAS unsigned char* va = lds + ((t_ + 3) & 3) * ATB + vfo; ATT_VF_LO(va); \
    _Pragma("unroll") for (int i = 0; i < 8; ++i) { ATT_PVMMA(i); if (i < 4) vf[i] = *(const LAS bf16x8*)((va) + 64 + (i >> 1) * 16 + (i & 1) * 32 * VSTR); } \
    ATT_BAR(); if (ld2) ATT_STORE((t_ + 2) & 3); ATT_BAR(); } while (0)
#define ATT_IDLE(t) do { const int t_ = (t); const bool ld2 = t_ + 2 < NT && !nomem; if (ld2) ATT_LOAD(t_ + 2); ATT_BAR(); if (ld2) ATT_STORE((t_ + 2) & 3); ATT_BAR(); } while (0)
    const bool grpB = tid >= 256;
    if (grpB) __syncthreads();
    int t = 0;
    if (active) {
        ATT_FIRST(sA0, sA1, sB0, sB1); t = 1;
        while (t <= wlim) {
            ATT_FULL(sB0, sB1, sA0, sA1, t); ++t;
            if (t > wlim) break;
            ATT_FULL(sA0, sA1, sB0, sB1, t); ++t;
        }
        ATT_LAST(t); ++t;
    }
    for (; t <= NT; ++t) ATT_IDLE(t);
    if (!grpB) __syncthreads();
    __syncthreads();
    if (active && !nomem) {
        const float inv = 1.0f / xsum32(lrun);
        bf16_t* op = C.mix() + (size_t)qrow * DM + h * 64 + hi * 16;
        f32x4 a, b;
        a = (f32x4){o0[0], o0[1], o0[2], o0[3]} * inv; b = (f32x4){o0[4], o0[5], o0[6], o0[7]} * inv; st_bf16x8(op, a, b);
        a = (f32x4){o0[8], o0[9], o0[10], o0[11]} * inv; b = (f32x4){o0[12], o0[13], o0[14], o0[15]} * inv; st_bf16x8(op + 8, a, b);
        a = (f32x4){o1[0], o1[1], o1[2], o1[3]} * inv; b = (f32x4){o1[4], o1[5], o1[6], o1[7]} * inv; st_bf16x8(op + 32, a, b);
        a = (f32x4){o1[8], o1[9], o1[10], o1[11]} * inv; b = (f32x4){o1[12], o1[13], o1[14], o1[15]} * inv; st_bf16x8(op + 40, a, b);
    }
#undef ATT_FIRST
#undef ATT_FULL
#undef ATT_LAST
#undef ATT_IDLE
#undef ATT_MAXUPD
#undef ATT_QK_SUM
#undef ATT_LOAD
#undef ATT_STORE
}

#define XB_TMO      128
#define XB_XCNT(j)  (256  + 64 * (j))
#define XB_XSUB(j)  (1280 + 64 * (j))
#define XB_XGEN(j)  (2304 + 64 * (j))
#define XB_TOP      3328
#define XB_TOPGEN   3392
#define XCD_BAR_WORDS 3456
#define XB_SPIN_CAP (1u << 18)

__device__ __forceinline__ unsigned xb_ld(unsigned* p)              { return __hip_atomic_load(p, __ATOMIC_RELAXED, __HIP_MEMORY_SCOPE_AGENT); }
__device__ __forceinline__ unsigned xb_add(unsigned* p, unsigned v) { return __hip_atomic_fetch_add(p, v, __ATOMIC_RELAXED, __HIP_MEMORY_SCOPE_AGENT); }
__device__ __forceinline__ unsigned xb_xcc_id() { return (unsigned)__builtin_amdgcn_s_getreg((3 << 11) | 20) & 0xFu; }
#define XB_SPIN(cond, bar) do { unsigned _sp = 0; while (cond) { __builtin_amdgcn_s_sleep(1); \
    if ((++_sp & 255u) == 0u) { if (xb_ld(&(bar)[XB_TMO])) break; if (_sp > XB_SPIN_CAP) { atomicAdd(&(bar)[XB_TMO], 1u); break; } } } } while (0)

struct XcdBarrier {
    unsigned* bar; unsigned x;
    volatile LAS unsigned* st;
};

__device__ __forceinline__ XcdBarrier xcd_barrier_post(unsigned* bar, volatile LAS unsigned* st) {
    XcdBarrier b; b.bar = bar; b.x = xb_xcc_id(); b.st = st;
    if (threadIdx.x == 0) (void)xb_add(&bar[XB_XCNT(b.x)], 1u);
    return b;
}
__device__ __forceinline__ void xcd_barrier_complete(unsigned* bar, unsigned x, unsigned& nloc, unsigned& nx) {
    const unsigned G = gridDim.x * gridDim.y * gridDim.z;
    unsigned sum, cnt, mine, sp = 0u;
    for (;;) {
        sum = 0u; cnt = 0u; mine = 0u;
#pragma unroll
        for (unsigned j = 0; j < 16; ++j) { const unsigned c = xb_ld(&bar[XB_XCNT(j)]); sum += c; cnt += (c > 0u) ? 1u : 0u; mine = (j == x) ? c : mine; }
        if (sum == G) break;
        __builtin_amdgcn_s_sleep(1);
        if ((++sp & 255u) == 0u) { if (xb_ld(&bar[XB_TMO])) break; if (sp > XB_SPIN_CAP) { atomicAdd(&bar[XB_TMO], 1u); break; } }
    }
    nloc = mine > 0u ? mine : 1u; nx = cnt > 0u ? cnt : 1u;
}

__device__ __forceinline__ void xcd_barrier(const XcdBarrier& b) {
    asm volatile("s_waitcnt vmcnt(0)" ::: "memory");
    __syncthreads();
    if (threadIdx.x == 0) {
        unsigned* bar = b.bar;
        __builtin_amdgcn_s_waitcnt(0);
        unsigned nloc = b.st[0], nx = b.st[1];
        if (nloc == 0u) { xcd_barrier_complete(bar, b.x, nloc, nx); b.st[0] = nloc; b.st[1] = nx; }
        const unsigned old = xb_add(&bar[XB_XSUB(b.x)], 1u);
        const unsigned gen = old / nloc;
        if (old + 1u == (gen + 1u) * nloc) {
            __builtin_amdgcn_fence(__ATOMIC_RELEASE, "agent");
            asm volatile("s_waitcnt vmcnt(0)" ::: "memory");
            const unsigned og = xb_add(&bar[XB_TOP], 1u);
            const unsigned tg = og / nx;
            if (og + 1u == (tg + 1u) * nx) xb_add(&bar[XB_TOPGEN], 1u);
            else XB_SPIN(xb_ld(&bar[XB_TOPGEN]) == tg, bar);
            __builtin_amdgcn_fence(__ATOMIC_ACQUIRE, "agent");
            xb_add(&bar[XB_XGEN(b.x)], 1u);
            asm volatile("s_waitcnt vmcnt(0)" ::: "memory");
        } else {
            XB_SPIN(xb_ld(&bar[XB_XGEN(b.x)]) == gen, bar);
            __builtin_amdgcn_fence(__ATOMIC_ACQUIRE, "agent");
            asm volatile("s_waitcnt vmcnt(0)" ::: "memory");
        }
    }
    __syncthreads();
}

__global__ void __launch_bounds__(512, 2) fwd_kernel(Params prm) {
    extern __shared__ __attribute__((aligned(16))) unsigned char lds_raw[];
    cg::grid_group grid = cg::this_grid();
    LAS unsigned char* lds = (LAS unsigned char*)lds_raw;
#define FRESH_TID() int tid = threadIdx.x; asm volatile("" : "+v"(tid)); const int lane = tid & 63, wave = __builtin_amdgcn_readfirstlane(tid >> 6); \
    const int gw = vcu * 8 + wave, NGW = G * 8; const size_t gtid = (size_t)bid * 512 + tid, gsz = (size_t)G * 512; (void)lane; (void)gw; (void)NGW; (void)gtid; (void)gsz
    const int G = gridDim.x, bid = blockIdx.x;
    const int vcu = (G % 8 == 0) ? (bid % 8) * (G / 8) + bid / 8 : bid;
    Ctx C; C.p = prm;
    volatile LAS unsigned* bst = (volatile LAS unsigned*)(lds + 131072 + 64);
    if (threadIdx.x < 2) bst[threadIdx.x] = 0u;
    __syncthreads();
    const XcdBarrier xbar = xcd_barrier_post((unsigned*)(prm.ws + OFF_BAR), bst);
#define GRID_BAR() xcd_barrier(xbar)

#ifndef REP_PRO
#define REP_PRO 1
#endif
    for (int rep0 = 0; rep0 < REP_PRO; ++rep0) {
    { FRESH_TID();
    for (int it = bid; it < 96; it += G) gemv_item<0>(C, lds, prm.w_ada, 6144, it * 64, prm.b_ada, C.mod(), 6144, tid, wave, lane);
    {
        LAS float* scr = (LAS float*)lds + wave * (64 * 33);
        constexpr int I0 = 16 * 88, I1 = 12 * 24, I2 = 4 * 16, I3 = 4 * 16, I4 = 16 * 32, I5 = 16 * 176, I6 = 44 * 32;
        constexpr int NIT = I0 + I1 + I2 + I3 + I4 + I5 + I6;
        for (int it = gw; it < NIT; it += NGW) {
            int r = it, mat, K, nblk; bf16_t* WT;
            if (r < I0) { mat = 0; K = 1024; nblk = 88; WT = C.Win(); }
            else if ((r -= I0) < I1) { mat = 1; K = 768; nblk = 24; WT = C.Wuq(); }
            else if ((r -= I1) < I2) { mat = 2; K = 256; nblk = 16; WT = C.Wkn(); }
            else if ((r -= I2) < I3) { mat = 3; K = 256; nblk = 16; WT = C.Wv(); }
            else if ((r -= I3) < I4) { mat = 4; K = 1024; nblk = 32; WT = C.Wout(); }
            else if ((r -= I4) < I5) { mat = 5; K = 1024; nblk = 176; WT = C.Wgu(); }
            else { r -= I5; mat = 6; K = 2816; nblk = 32; WT = C.Wdn(); }
            transpose_item(C, mat, K, WT, scr, r, nblk, lane);
        }
        for (size_t idx0 = gtid; idx0 < (size_t)32 * PAST * 32; idx0 += 4 * gsz) {
            f32x4 a[4], c[4];
#pragma unroll
            for (int u = 0; u < 4; ++u) { const size_t idx = idx0 + u * gsz; if (idx < (size_t)32 * PAST * 32) { const float* s = prm.cache_lat + idx * 8; a[u] = *(const f32x4*)s; c[u] = *(const f32x4*)(s + 4); } }
#pragma unroll
            for (int u = 0; u < 4; ++u) { const size_t idx = idx0 + u * gsz; if (idx < (size_t)32 * PAST * 32) {
                const int bt = (int)(idx >> 5), c8 = (int)(idx & 31) * 8, bb = bt >> 11, t = bt & 2047;
                st_bf16x8(C.lat() + (size_t)(TP + bb * TKS + t) * 256 + c8, a[u], c[u]); } }
        }
        for (size_t idx = gtid; idx < (size_t)32 * PAST * 4; idx += gsz) {
            const int bt = (int)(idx >> 2), c8 = (int)(idx & 3) * 8, bb = bt >> 11, t = bt & 2047;
            const float* s = prm.cache_kr + (size_t)bt * 32 + c8;
            st_bf16x8(C.krb() + (size_t)(TP + bb * TKS + t) * 32 + c8, *(const f32x4*)s, *(const f32x4*)(s + 4));
        }
    }
    }
    if (prm.ws == nullptr) grid.sync();
    GRID_BAR();

    { FRESH_TID();
    for (int it = bid; it < 88; it += G) {
        const bool up = it >= 44;
        gemv_item<1>(C, lds, up ? prm.w_up : prm.w_gate, 2816, (up ? it - 44 : it) * 64, nullptr, up ? C.bu() : C.bg(), 2816, tid, wave, lane);
    }
    for (int row4 = gw * 4; row4 < MT; row4 += NGW * 4) {
        const float* xr = row4 < TP ? prm.x_p + (size_t)row4 * DM : prm.x_s + (size_t)(row4 - TP) * DM;
        const float* mb = C.mod() + (size_t)batch_of(row4) * 6144;
        f32x4 v[4][4]; float s[4];
#pragma unroll
        for (int r = 0; r < 4; ++r)
#pragma unroll
            for (int j = 0; j < 4; ++j) v[r][j] = *(const f32x4*)(xr + (size_t)r * DM + 4 * lane + 256 * j);
#pragma unroll
        for (int r = 0; r < 4; ++r) s[r] = dot4(v[r][0]) + dot4(v[r][1]) + dot4(v[r][2]) + dot4(v[r][3]);
#pragma unroll
        for (int o = 1; o < 64; o <<= 1) {
#pragma unroll
            for (int r = 0; r < 4; ++r) s[r] += __shfl_xor(s[r], o);
        }
#pragma unroll
        for (int r = 0; r < 4; ++r) s[r] = rsqrtf(s[r] * (1.0f / 1024.0f) + EPS);
#pragma unroll
        for (int j = 0; j < 4; ++j) {
            const int k = 4 * lane + 256 * j;
            const f32x4 g = *(const f32x4*)(prm.norm_mix_g + k), sh = *(const f32x4*)(mb + k), sc = *(const f32x4*)(mb + 1024 + k);
            const f32x4 gs = g * (sc + 1.0f);
#pragma unroll
            for (int r = 0; r < 4; ++r) {
                const f32x4 hv = v[r][j] * s[r] * gs + sh;
                u32x2 w; w.x = pk2(hv[0], hv[1]); w.y = pk2(hv[2], hv[3]);
                *(u32x2*)(C.h1() + (size_t)(row4 + r) * DM + k) = w;
            }
        }
    }
    }
    GRID_BAR();
    }

#ifdef PROBE_SYNC
    for (int i = 0; i < PROBE_SYNC; ++i) GRID_BAR();
#endif
#pragma nounroll
    for (int job = 0; job < 8; ++job) {
        pg8::Gemm g; int rot = 0;
        if (job == 0) { g.A = C.h1(); g.Bt = C.Win(); g.M = MT; g.N = NIN; g.K = 1024; }
        else if (job == 1) { g.A = C.cq(); g.Bt = C.Wuq(); g.M = MT; g.N = 768; g.K = 768; }
        else if (job == 2) { g.A = C.lat(); g.Bt = C.Wkn(); g.M = LROWS; g.N = 512; g.K = 256; rot = 12; }
        else if (job == 3) { g.A = C.Wv(); g.Bt = C.lat(); g.M = 512; g.N = LROWS; g.K = 256; rot = 20; }
        else if (job == 4) { g.A = C.mix(); g.Bt = C.Wout(); g.M = MT; g.N = 1024; g.K = 1024; }
        else if (job == 5) { g.A = C.A2(); g.Bt = C.Wgu(); g.M = MT; g.N = NGU; g.K = 1024; }
        else if (job == 6) { g.A = C.hff(); g.Bt = C.Wdn(); g.M = TP; g.N = 1024; g.K = 2816; }
        else { g.A = C.hff() + (size_t)TP * DFF; g.Bt = C.Wdn(); g.M = TS; g.N = 1024; g.K = 256; rot = 40; }
        g.ld = g.K; if (job == 7) g.ld = DFF;
        pg8::StaticOrder S; S.init(g.M, g.N, G, (bid + G - rot % G) % G);
        if (job == 7) S.split = 11;
        if (job == 5 || job == 1 || job == 2) S.rev = 1;
        if (job == 3) S.revn = 1;
        EpiAll E{C, job};
#ifndef REPMASK
#define REPMASK 0
#endif
        const int nrep = 1 + ((REPMASK >> job) & 1);
#pragma nounroll
        for (int rep = 0; rep < nrep; ++rep) {
#ifdef REP_NOEPI
        if (rep == 1) E.mode = 99;
#endif
        pg8::gemm_phase<EpiAll, pg8::StaticOrder, true, true>(lds, g, S, E);
        }
        if (job == 1 || job == 2 || job == 6) continue;
        if (job == 3) {
            { FRESH_TID();
            {
                const int c8 = (int)(gtid & 63) * 8;
                float w0[8], w1[8], w2[8], cb[8];
#pragma unroll
                for (int i = 0; i < 8; ++i) { w0[i] = prm.conv_w[c8 + i]; w1[i] = prm.conv_w[512 + c8 + i]; w2[i] = prm.conv_w[1024 + c8 + i]; cb[i] = prm.conv_b[c8 + i]; }
                for (int q = (int)(gtid >> 6); q < MT / 4; q += (int)(gsz >> 6)) {
                    const int row = q * 4, t0 = row < TP ? (row & 8191) : ((row - TP) & 31);
                    u32x4 gw_[6], gq_[4];
#pragma unroll
                    for (int r = 0; r < 4; ++r) { gw_[2 + r] = *(const u32x4*)(C.gi() + (size_t)(row + r) * 512 + c8); gq_[r] = *(const u32x4*)(C.gb() + (size_t)(row + r) * 512 + c8); }
                    float e[6][8];
                    if (t0 != 0) { gw_[0] = *(const u32x4*)(C.gi() + (size_t)(row - 2) * 512 + c8); gw_[1] = *(const u32x4*)(C.gi() + (size_t)(row - 1) * 512 + c8); }
                    else { gw_[0] = (u32x4){0, 0, 0, 0}; gw_[1] = (u32x4){0, 0, 0, 0}; }
#pragma unroll
                    for (int r = 0; r < 6; ++r)
#pragma unroll
                        for (int i = 0; i < 4; ++i) { e[r][2 * i] = __uint_as_float(gw_[r][i] << 16); e[r][2 * i + 1] = __uint_as_float(gw_[r][i] & 0xffff0000u); }
                    if (t0 == 0 && row >= TP) {
                        const float* sc = prm.state_conv + (size_t)((row - TP) >> 5) * 1024 + c8;
#pragma unroll
                        for (int i = 0; i < 8; ++i) { e[0][i] = sc[i]; e[1][i] = sc[512 + i]; }
                    }
#pragma unroll
                    for (int r = 0; r < 4; ++r) {
                        float y[8];
#pragma unroll
                        for (int i = 0; i < 4; ++i) {
                            const float g0 = __uint_as_float(gq_[r][i] << 16), g1 = __uint_as_float(gq_[r][i] & 0xffff0000u);
                            y[2 * i] = g0 * (w0[2 * i] * e[r][2 * i] + w1[2 * i] * e[r + 1][2 * i] + w2[2 * i] * e[r + 2][2 * i] + cb[2 * i]);
                            y[2 * i + 1] = g1 * (w0[2 * i + 1] * e[r][2 * i + 1] + w1[2 * i + 1] * e[r + 1][2 * i + 1] + w2[2 * i + 1] * e[r + 2][2 * i + 1] + cb[2 * i + 1]);
                        }
                        st_bf16x8(C.mix() + (size_t)(row + r) * DM + 512 + c8, (f32x4){y[0], y[1], y[2], y[3]}, (f32x4){y[4], y[5], y[6], y[7]});
                    }
                }
            }
            {
                for (int row8 = gw * 8; row8 < MT; row8 += NGW * 8) {
                    float* o = C.p.out + (row8 < TP ? OLP + (size_t)row8 * 256 : OLS + (size_t)(row8 - TP) * 256) + lane * 4;
                    const bf16_t* src = C.lat() + (size_t)latrow_of(row8) * 256 + lane * 4;
                    u32x2 w[8]; f32x4 sv[8];
#pragma unroll
                    for (int r = 0; r < 8; ++r) { w[r] = *(const u32x2*)(src + r * 256); sv[r] = *(const f32x4*)(C.ssq_kv() + (size_t)(row8 + r) * 4); }
#pragma unroll
                    for (int r = 0; r < 8; ++r) { const float rs = rsqrtf(sum4(sv[r]) * (1.0f / 256.0f) + EPS);
                        *(f32x4*)(o + r * 256) = (f32x4){__uint_as_float(w[r].x << 16), __uint_as_float(w[r].x & 0xffff0000u), __uint_as_float(w[r].y << 16), __uint_as_float(w[r].y & 0xffff0000u)} * rs; }
                }
            }
            }
            GRID_BAR();
            FRESH_TID();
#ifndef REP_ATTN
#define REP_ATTN 1
#endif
            for (int rep = 0; rep < REP_ATTN; ++rep)
            for (int it = vcu; it < 1024 + 256; it += G) {
                const int nsub = it < 1024 ? 2 : 1;
                for (int sub = 0; sub < nsub; ++sub) {
                    int kvbase, NT, wlim, qrow, h; bool half_last;
                    if (it < 1024) { const int bh = it >> 4, s = it & 15, qt = sub ? 31 - s : s, b = bh >> 3; h = bh & 7;
                        kvbase = b * 8192; NT = 4 * qt + 4; wlim = 4 * qt + (wave >> 1); half_last = false; qrow = b * 8192 + 256 * qt + 32 * wave + (lane & 31); }
                    else { const int su = it - 1024, b = su >> 3; h = su & 7;
                        kvbase = TP + b * TKS; NT = 33; wlim = wave == 0 ? 32 : -1; half_last = true; qrow = TP + b * 32 + (lane & 31); }
#if defined(PROBE_ATT) && PROBE_ATT == 2
                    if (rep == 1) wlim = -1;
#endif
#if defined(PROBE_ATT) && PROBE_ATT == 1
                    attn_unit(C, lds, kvbase, NT, wlim, half_last, qrow, h, tid, lane, rep == 1);
#else
                    attn_unit(C, lds, kvbase, NT, wlim, half_last, qrow, h, tid, lane, false);
#endif
                }
            }
        }
        GRID_BAR();
    }
    FRESH_TID();
    for (int row4 = gw * 4; row4 < MT; row4 += NGW * 4) {
        const bf16_t* xr = C.xb() + (size_t)row4 * DM + 8 * lane;
        f32x4 v[4][4];
#pragma unroll
        for (int r = 0; r < 4; ++r) { ld_bf16x8(xr + (size_t)r * DM, v[r][0], v[r][1]); ld_bf16x8(xr + (size_t)r * DM + 512, v[r][2], v[r][3]); }
        if (row4 >= TP) {
            const float* mb = C.mod() + (size_t)(8 + ((row4 - TP) >> 5)) * 6144 + 5120 + 8 * lane;
            f32x4 a[4][4];
#pragma unroll
            for (int r = 0; r < 4; ++r)
#pragma unroll
                for (int j = 0; j < 4; ++j) a[r][j] = (f32x4){0.f, 0.f, 0.f, 0.f};
            for (int kc = 0; kc < 11; ++kc) {
                const float* pp = C.part() + ((size_t)kc * 1024 + (row4 - TP)) * 1024 + 8 * lane;
#pragma unroll
                for (int r = 0; r < 4; ++r)
#pragma unroll
                    for (int j = 0; j < 4; ++j) a[r][j] += *(const f32x4*)(pp + (size_t)r * 1024 + (j >> 1) * 512 + (j & 1) * 4);
            }
#pragma unroll
            for (int j = 0; j < 4; ++j) { const f32x4 g2 = *(const f32x4*)(mb + (j >> 1) * 512 + (j & 1) * 4);
#pragma unroll
                for (int r = 0; r < 4; ++r) v[r][j] += g2 * a[r][j]; }
        }
        float rs[4];
#pragma unroll
        for (int r = 0; r < 4; ++r) rs[r] = dot4(v[r][0]) + dot4(v[r][1]) + dot4(v[r][2]) + dot4(v[r][3]);
#pragma unroll
        for (int of = 1; of < 64; of <<= 1) {
#pragma unroll
            for (int r = 0; r < 4; ++r) rs[r] += __shfl_xor(rs[r], of);
        }
#pragma unroll
        for (int r = 0; r < 4; ++r) rs[r] = rsqrtf(rs[r] * (1.0f / 1024.0f) + EPS);
        float* o = C.p.out + OY + (size_t)row4 * DM + 8 * lane;
#pragma unroll
        for (int j = 0; j < 4; ++j) {
            const int co = (j >> 1) * 512 + (j & 1) * 4;
            const f32x4 g = *(const f32x4*)(prm.final_g + 8 * lane + co);
#pragma unroll
            for (int r = 0; r < 4; ++r) *(f32x4*)(o + (size_t)r * DM + co) = v[r][j] * rs[r] * g;
        }
    }
}

extern "C" void kernel_launch(void* const* d_in, const int* in_sizes, int n_in, void* d_out, int out_size, void* d_ws, size_t ws_size, hipStream_t stream) {
    static int grid = 0;
    if (grid == 0) {
        int dev = 0, cus = 0, per_cu = 0;
        if (n_in != 23 || ws_size < WS_NEED) { fprintf(stderr, "kernel_launch: unexpected inputs (n_in %d, ws %zu)\n", n_in, ws_size); grid = -1; return; }
        hipGetDevice(&dev);
        hipDeviceGetAttribute(&cus, hipDeviceAttributeMultiprocessorCount, dev);
        hipFuncSetAttribute((const void*)fwd_kernel, hipFuncAttributeMaxDynamicSharedMemorySize, LDS_BYTES);
        hipOccupancyMaxActiveBlocksPerMultiprocessor(&per_cu, (const void*)fwd_kernel, 512, LDS_BYTES);
        if (per_cu < 1) per_cu = 1;
        grid = cus * per_cu;
        (void)hipGetLastError();
    }
    if (grid < 0) return;
    if (hipMemsetAsync((char*)d_ws + OFF_BAR, 0, 3456 * 4, stream) != hipSuccess) { fprintf(stderr, "kernel_launch: memset of the barrier words failed\n"); return; }
    Params p{};
    const float** f = (const float**)&p;
    for (int i = 0; i < 23; ++i) f[i] = (const float*)d_in[i];
    p.out = (float*)d_out; p.ws = (unsigned char*)d_ws;
    void* args[] = {&p};
    hipError_t e = hipLaunchCooperativeKernel((const void*)fwd_kernel, dim3(grid), dim3(512), args, LDS_BYTES, stream);
    if (e != hipSuccess) fprintf(stderr, "cooperative launch failed: %s (grid %d)\n", hipGetErrorString(e), grid);
}
```

```cpp
#include <hip/hip_runtime.h>
#include <hip/hip_cooperative_groups.h>
#include <cstdio>
#include <cstdint>
#include <cmath>
namespace cg = cooperative_groups;
namespace pg8 {
#define PG8_LAS __attribute__((address_space(3)))
typedef unsigned short bf16_t;
typedef short bf16x8 __attribute__((ext_vector_type(8)));
typedef float f32x4 __attribute__((ext_vector_type(4)));
typedef unsigned u32x4 __attribute__((ext_vector_type(4)));
constexpr int BM = 256, BK = 64, HALF = 128, HTB = HALF * BK * 2  , STAGE_BYTES = 8 * HTB, NXCD = 8, WGM = 8;

__host__ __device__ __forceinline__ int lds_byte(int r, int c) { const int st = (r >> 4) * 2 + (c >> 5), rr = r & 15, cc = c & 31, ob = rr * 64 + cc * 2; return st * 1024 + (ob ^ (((ob >> 9) & 1) << 5)); }
__host__ __device__ __forceinline__ void stage_rc(int b, int& R, int& C) { const int st = b / 1024, sb = b % 1024, swz = sb ^ (((sb >> 9) & 1) << 5); R = (st >> 1) * 16 + swz / 64; C = (st & 1) * 32 + (swz % 64) / 2; }
__host__ __device__ __forceinline__ int perm32(int rho) { const int n = rho >> 4, i = rho & 15; return 8 * (i >> 2) + 4 * n + (i & 3); }

struct Unit { int pm, pn, kc; };
struct Gemm { const bf16_t* A; const bf16_t* Bt; int M, N, K, ld; };

struct StaticOrder {
    int nM, nN, nwg, G, c, split, rev;
    __host__ __device__ void init(int M, int N, int G_, int c_) { nM = M / BM; nN = N / BM; nwg = nM * nN; G = G_; c = c_; split = 0; rev = 0; }
    __host__ __device__ bool next(int i, Unit& u) const {
        u.kc = 0;
        if (split) { if (i != 0 || c >= split * nwg) return false; u.kc = c / nwg; const int r = c % nwg; u.pm = r / nN; u.pn = r % nN; return true; }
        const long L = (long)i * G + c; if (L >= nwg) return false;
        int wgid = (int)L; { const int q = nwg / NXCD, r = nwg % NXCD, xcd = wgid % NXCD, off = wgid / NXCD; wgid = (xcd < r ? xcd * (q + 1) : r * (q + 1) + (xcd - r) * q) + off; }
        const int nig = WGM * nN, gid = wgid / nig, fm = gid * WGM, gsz = (nM - fm) < WGM ? (nM - fm) : WGM;
        u.pm = fm + ((wgid % nig) % gsz); u.pn = (wgid % nig) / gsz; if (rev) u.pm = nM - 1 - u.pm; return true;
    }
    __device__ __forceinline__ void a_ready(const Unit&) const {}
    __device__ __forceinline__ void done(const Unit&) const {}
};
__device__ __forceinline__ unsigned cvt_pk_bf16(float lo, float hi) { unsigned r; asm volatile("v_cvt_pk_bf16_f32 %0, %1, %2" : "=v"(r) : "v"(lo), "v"(hi)); return r; }
template <class Epi, class Sched, bool ALIGN_EPI = false, bool SP2 = false>
__device__ __forceinline__ void gemm_phase(PG8_LAS unsigned char* lds, const Gemm g, const Sched& S, const Epi& E) {
    int tid_ = threadIdx.x; asm volatile("" : "+v"(tid_));
    const int tid = tid_, wid = __builtin_amdgcn_readfirstlane(tid >> 6), lane = tid & 63, wr = wid >> 2, wc = wid & 3, fr = lane & 15, fq = lane >> 4;
    const int K = g.K, nt = K / BK;
    unsigned voffA[2], voffB[2];
#pragma unroll
    for (int i = 0; i < 2; ++i) { int R, C; stage_rc(tid * 16 + i * 8192, R, C); const int Rb = Epi::PERM ? ((R & ~31) + perm32(R & 31)) : R;
        voffA[i] = (unsigned)(R * g.ld + C) * 2u; voffB[i] = (unsigned)(Rb * g.ld + C) * 2u; }
    const size_t kstep = (size_t)(BK * 2);
    const size_t hstep = (size_t)HALF * g.ld * 2;
    const size_t tstep = 2 * hstep;
    const unsigned ldsw = (unsigned)wid * 1024u;
    const int aoff = lds_byte(wr * 64 + fr, fq * 8), boff = lds_byte(wc * 32 + fr, fq * 8);
#define PG8_SA(b, h) (((b) * 2 + (h)) * HTB)
#define PG8_SB(b, h) ((4 + (b) * 2 + (h)) * HTB)
#define PG8_STAGE(bufoff, gbase, voff) do { _Pragma("unroll") for (int _i = 0; _i < 2; ++_i) \
        __builtin_amdgcn_global_load_lds((const unsigned*)((const char*)(gbase) + (voff)[_i]), (PG8_LAS unsigned*)(lds + (bufoff) + ldsw + _i * 8192), 16, 0, 0); } while (0)
#define PG8_LDA(dst, b, h) do { _Pragma("unroll") for (int m = 0; m < 4; ++m) _Pragma("unroll") for (int k = 0; k < 2; ++k) dst[m][k] = *(const PG8_LAS bf16x8*)(lds + PG8_SA(b, h) + aoff + m * 2048 + k * 1024); } while (0)
#define PG8_LDB(dst, b, h) do { _Pragma("unroll") for (int n = 0; n < 2; ++n) _Pragma("unroll") for (int k = 0; k < 2; ++k) dst[n][k] = *(const PG8_LAS bf16x8*)(lds + PG8_SB(b, h) + boff + n * 2048 + k * 1024); } while (0)
#define PG8_MMA(ai, bj, At, Bt) do { __builtin_amdgcn_s_setprio(1); _Pragma("unroll") for (int m = 0; m < 4; ++m) _Pragma("unroll") for (int n = 0; n < 2; ++n) _Pragma("unroll") for (int k = 0; k < 2; ++k) \
        acc[ai][bj][m][n] = __builtin_amdgcn_mfma_f32_16x16x32_bf16(Bt[n][k], At[m][k], acc[ai][bj][m][n], 0, 0, 0); __builtin_amdgcn_s_setprio(0); } while (0)
#define PG8_WAIT_V(n) asm volatile("s_waitcnt vmcnt(" #n ")" ::: "memory")
#define PG8_WAIT_L(n) asm volatile("s_waitcnt lgkmcnt(" #n ")" ::: "memory")
#define PG8_BAR __builtin_amdgcn_s_barrier()
#define PG8_SCHED __builtin_amdgcn_sched_barrier(0)
    Unit cur, nxt; int ui = 0;
    if (!S.next(0, cur)) return;
    f32x4 acc[2][2][4][2];
#pragma unroll
    for (int a = 0; a < 2; ++a)
#pragma unroll
        for (int b = 0; b < 2; ++b)
#pragma unroll
            for (int m = 0; m < 4; ++m)
#pragma unroll
                for (int n = 0; n < 2; ++n) acc[a][b][m][n] = (f32x4){0.f, 0.f, 0.f, 0.f};
    bf16x8 At[4][2], B0[2][2], B1[2][2];
    const char* cA = (const char*)g.A + (size_t)cur.pm * tstep + (size_t)cur.kc * K * 2; const char* cB = (const char*)g.Bt + (size_t)cur.pn * tstep + (size_t)cur.kc * K * 2;
    S.a_ready(cur);
    if constexpr (SP2) {
        PG8_STAGE(PG8_SB(0, 0), cB, voffB); PG8_STAGE(PG8_SB(0, 1), cB + hstep, voffB); PG8_STAGE(PG8_SA(0, 0), cA, voffA); PG8_STAGE(PG8_SA(0, 1), cA + hstep, voffA);
        if (wr == 1) PG8_BAR;
        PG8_WAIT_V(2); PG8_BAR;
        PG8_STAGE(PG8_SB(1, 0), cB + kstep, voffB); PG8_STAGE(PG8_SA(1, 0), cA + kstep, voffA); PG8_STAGE(PG8_SB(1, 1), cB + hstep + kstep, voffB);
        PG8_WAIT_V(6); PG8_BAR;
    } else {
        PG8_STAGE(PG8_SB(0, 0), cB, voffB); PG8_STAGE(PG8_SA(0, 0), cA, voffA); PG8_STAGE(PG8_SB(0, 1), cB + hstep, voffB); PG8_STAGE(PG8_SA(0, 1), cA + hstep, voffA);
        if (wr == 1) PG8_BAR;
        PG8_WAIT_V(4); PG8_BAR;
        PG8_STAGE(PG8_SB(1, 0), cB + kstep, voffB); PG8_STAGE(PG8_SA(1, 0), cA + kstep, voffA); PG8_STAGE(PG8_SB(1, 1), cB + hstep + kstep, voffB);
        PG8_WAIT_V(6); PG8_BAR;
    }
    for (;;) {
        const bool has_next = S.next(ui + 1, nxt);
        const char* nA = has_next ? (const char*)g.A + (size_t)nxt.pm * tstep + (size_t)nxt.kc * K * 2 : cA; const char* nB = has_next ? (const char*)g.Bt + (size_t)nxt.pn * tstep + (size_t)nxt.kc * K * 2 : cB;
        for (int t = 0; t < nt; t += 2) {
            const bool last = (t == nt - 2);
            const char* a1 = cA + (size_t)(t + 1) * kstep;
            const char* a2 = last ? nA : cA + (size_t)(t + 2) * kstep; const char* b2 = last ? nB : cB + (size_t)(t + 2) * kstep;
            const char* a3 = a2 + kstep; const char* b3 = b2 + kstep;
            if (last && has_next) S.a_ready(nxt);
            if constexpr (SP2) {
            PG8_LDB(B0, 0, 0); PG8_LDB(B1, 0, 1); PG8_SCHED; PG8_LDA(At, 0, 0); PG8_STAGE(PG8_SA(1, 1), a1 + hstep, voffA);
            PG8_WAIT_V(8); PG8_WAIT_L(0); PG8_BAR; PG8_MMA(0, 0, At, B0); PG8_MMA(0, 1, At, B1); PG8_BAR; PG8_SCHED;
            PG8_LDA(At, 0, 1); PG8_STAGE(PG8_SB(0, 0), b2, voffB); PG8_STAGE(PG8_SB(0, 1), b2 + hstep, voffB); PG8_STAGE(PG8_SA(0, 0), a2, voffA);
            PG8_WAIT_V(8); PG8_WAIT_L(0); PG8_BAR; PG8_MMA(1, 0, At, B0); PG8_MMA(1, 1, At, B1); PG8_BAR; PG8_SCHED;
            PG8_LDB(B0, 1, 0); PG8_LDB(B1, 1, 1); PG8_SCHED; PG8_LDA(At, 1, 0); PG8_STAGE(PG8_SA(0, 1), a2 + hstep, voffA);
            PG8_WAIT_V(8); PG8_WAIT_L(0); PG8_BAR; PG8_MMA(0, 0, At, B0); PG8_MMA(0, 1, At, B1); PG8_BAR; PG8_SCHED;
            PG8_LDA(At, 1, 1); PG8_STAGE(PG8_SB(1, 0), b3, voffB); PG8_STAGE(PG8_SB(1, 1), b3 + hstep, voffB); PG8_STAGE(PG8_SA(1, 0), a3, voffA);
            PG8_WAIT_V(8); PG8_WAIT_L(0); PG8_BAR; PG8_MMA(1, 0, At, B0); PG8_MMA(1, 1, At, B1); PG8_BAR; PG8_SCHED;
            } else {
            PG8_LDB(B0, 0, 0); PG8_SCHED; PG8_LDA(At, 0, 0); PG8_STAGE(PG8_SA(1, 1), a1 + hstep, voffA);
            PG8_WAIT_L(8); PG8_BAR; PG8_WAIT_L(0); PG8_MMA(0, 0, At, B0); PG8_BAR; PG8_SCHED;
            PG8_LDB(B1, 0, 1); PG8_STAGE(PG8_SB(0, 0), b2, voffB);
            PG8_BAR; PG8_WAIT_L(0); PG8_MMA(0, 1, At, B1); PG8_BAR;
            PG8_LDA(At, 0, 1); PG8_STAGE(PG8_SA(0, 0), a2, voffA);
            PG8_BAR; PG8_WAIT_L(0); PG8_MMA(1, 0, At, B0); PG8_BAR; PG8_SCHED;
            PG8_STAGE(PG8_SB(0, 1), b2 + hstep, voffB);
            PG8_WAIT_V(6); PG8_BAR; PG8_MMA(1, 1, At, B1); PG8_BAR;
            PG8_LDB(B0, 1, 0); PG8_SCHED; PG8_LDA(At, 1, 0); PG8_STAGE(PG8_SA(0, 1), a2 + hstep, voffA);
            PG8_WAIT_L(8); PG8_BAR; PG8_WAIT_L(0); PG8_MMA(0, 0, At, B0); PG8_BAR; PG8_SCHED;
            PG8_LDB(B1, 1, 1); PG8_STAGE(PG8_SB(1, 0), b3, voffB);
            PG8_BAR; PG8_WAIT_L(0); PG8_MMA(0, 1, At, B1); PG8_BAR;
            PG8_LDA(At, 1, 1); PG8_STAGE(PG8_SA(1, 0), a3, voffA);
            PG8_BAR; PG8_WAIT_L(0); PG8_MMA(1, 0, At, B0); PG8_BAR; PG8_SCHED;
            PG8_STAGE(PG8_SB(1, 1), b3 + hstep, voffB);
            PG8_WAIT_V(6); PG8_BAR; PG8_MMA(1, 1, At, B1); PG8_BAR;
            }
        }
        if constexpr (ALIGN_EPI) { if (wr == 0) PG8_BAR; }
        if constexpr (!Epi::AFTER_DRAIN) { E(acc, cur, wr, wc, fr, fq); S.done(cur); }
        if (!has_next) break;
#pragma unroll
        for (int a = 0; a < 2; ++a)
#pragma unroll
            for (int b = 0; b < 2; ++b)
#pragma unroll
                for (int m = 0; m < 4; ++m)
#pragma unroll
                    for (int n = 0; n < 2; ++n) acc[a][b][m][n] = (f32x4){0.f, 0.f, 0.f, 0.f};
        cur = nxt; cA = nA; cB = nB; ++ui;
        if constexpr (ALIGN_EPI) { if (wr == 1) PG8_BAR; }
    }
    PG8_WAIT_V(0);
    if constexpr (!ALIGN_EPI) { if (wr == 0) PG8_BAR; }
    PG8_BAR;
    if constexpr (Epi::AFTER_DRAIN) { E.fused(acc, cur, wr, wc, fr, fq, lds, wid, lane); S.done(cur); }
#undef PG8_SA
#undef PG8_SB
#undef PG8_STAGE
#undef PG8_LDA
#undef PG8_LDB
#undef PG8_MMA
#undef PG8_WAIT_V
#undef PG8_WAIT_L
#undef PG8_BAR
#undef PG8_SCHED
}
}

#define LAS __attribute__((address_space(3)))
typedef unsigned short bf16_t;
typedef short bf16x8 __attribute__((ext_vector_type(8)));
typedef float f32x4 __attribute__((ext_vector_type(4)));
typedef float f32x16 __attribute__((ext_vector_type(16)));
typedef unsigned u32x4 __attribute__((ext_vector_type(4)));
typedef unsigned u32x2 __attribute__((ext_vector_type(2)));

constexpr int DM = 1024, TP = 65536, TS = 1024, MT = TP + TS;
constexpr int PAST = 2048, TKS = 2080;
constexpr int LROWS = TP + 32 * TKS;
constexpr int LV = LROWS + 256;
constexpr int NIN = 2816, DFF = 2816, NGU = 5632;
constexpr float EPS = 1e-6f;
constexpr float QSCALE = 0.14724444602590306f;

constexpr unsigned OY = 0, OLP = 68157440, OKP = 84934656, OCP = 87031808, OLS = 87040000, OKS = 87302144, OCS = 87334912;

constexpr size_t MiB = 1u << 20;
constexpr size_t OFF_MOD = 0, OFF_BG = 1 * MiB, OFF_BU = 1 * MiB + 512 * 1024, OFF_SSQQ = 2 * MiB, OFF_SSQKV = 6 * MiB + 512 * 1024, OFF_SSQ1 = 8 * MiB, OFF_SSQ2 = 13 * MiB;
constexpr size_t OFF_WIN = 18 * MiB, OFF_WUQ = 24 * MiB, OFF_WKN = 26 * MiB, OFF_WV = 27 * MiB, OFF_WOUT = 28 * MiB, OFF_WGU = 30 * MiB, OFF_WDN = 41 * MiB;
constexpr size_t OFF_CQ = 48 * MiB, OFF_LAT = 146 * MiB, OFF_GI = 211 * MiB, OFF_GB = 276 * MiB, OFF_KRB = 341 * MiB, OFF_A2 = 48 * MiB;
constexpr size_t OFF_QN = 350 * MiB, OFF_QR = 415 * MiB, OFF_KN = 448 * MiB, OFF_VT = 577 * MiB, OFF_MIX = 707 * MiB, OFF_H1 = 448 * MiB, OFF_HFF = 350 * MiB;
constexpr size_t OFF_BAR = 1000 * 1024;
constexpr size_t WS_NEED = 838 * MiB;

constexpr int LDS_BYTES = 147456;

struct Params {
    const float *x_p, *x_s, *c_p, *c_s, *cache_lat, *cache_kr, *state_conv;
    const float *w_ada, *b_ada, *norm_mix_g, *w_in, *q_norm_g, *w_uq, *kv_norm_g, *w_ukv, *conv_w, *conv_b, *w_out, *norm_ffn_g, *w_gate, *w_up, *w_down, *final_g;
    float* out; unsigned char* ws;
};

struct Ctx {
    Params p;
    __device__ __forceinline__ float* mod() const { return (float*)(p.ws + OFF_MOD); }
    __device__ __forceinline__ float* bg() const { return (float*)(p.ws + OFF_BG); }
    __device__ __forceinline__ float* bu() const { return (float*)(p.ws + OFF_BU); }
    __device__ __forceinline__ float* ssq_q() const { return (float*)(p.ws + OFF_SSQQ); }
    __device__ __forceinline__ float* ssq_kv() const { return (float*)(p.ws + OFF_SSQKV); }
    __device__ __forceinline__ float* ssq_x1() const { return (float*)(p.ws + OFF_SSQ1); }
    __device__ __forceinline__ float* ssq_x2() const { return (float*)(p.ws + OFF_SSQ2); }
    __device__ __forceinline__ bf16_t* Win() const { return (bf16_t*)(p.ws + OFF_WIN); }
    __device__ __forceinline__ bf16_t* Wuq() const { return (bf16_t*)(p.ws + OFF_WUQ); }
    __device__ __forceinline__ bf16_t* Wkn() const { return (bf16_t*)(p.ws + OFF_WKN); }
    __device__ __forceinline__ bf16_t* Wv() const { return (bf16_t*)(p.ws + OFF_WV); }
    __device__ __forceinline__ bf16_t* Wout() const { return (bf16_t*)(p.ws + OFF_WOUT); }
    __device__ __forceinline__ bf16_t* Wgu() const { return (bf16_t*)(p.ws + OFF_WGU); }
    __device__ __forceinline__ bf16_t* Wdn() const { return (bf16_t*)(p.ws + OFF_WDN); }
    __device__ __forceinline__ bf16_t* cq() const { return (bf16_t*)(p.ws + OFF_CQ); }
    __device__ __forceinline__ bf16_t* lat() const { return (bf16_t*)(p.ws + OFF_LAT); }
    __device__ __forceinline__ bf16_t* gi() const { return (bf16_t*)(p.ws + OFF_GI); }
    __device__ __forceinline__ bf16_t* gb() const { return (bf16_t*)(p.ws + OFF_GB); }
    __device__ __forceinline__ bf16_t* krb() const { return (bf16_t*)(p.ws + OFF_KRB); }
    __device__ __forceinline__ bf16_t* A2() const { return (bf16_t*)(p.ws + OFF_A2); }
    __device__ __forceinline__ float* part() const { return (float*)(p.ws + OFF_A2); }
    __device__ __forceinline__ bf16_t* xb() const { return (bf16_t*)(p.ws + OFF_GI); }
    __device__ __forceinline__ bf16_t* Qn() const { return (bf16_t*)(p.ws + OFF_QN); }
    __device__ __forceinline__ bf16_t* Qr() const { return (bf16_t*)(p.ws + OFF_QR); }
    __device__ __forceinline__ bf16_t* Kn() const { return (bf16_t*)(p.ws + OFF_KN); }
    __device__ __forceinline__ bf16_t* Vt() const { return (bf16_t*)(p.ws + OFF_VT); }
    __device__ __forceinline__ bf16_t* mix() const { return (bf16_t*)(p.ws + OFF_MIX); }
    __device__ __forceinline__ bf16_t* h1() const { return (bf16_t*)(p.ws + OFF_H1); }
    __device__ __forceinline__ bf16_t* hff() const { return (bf16_t*)(p.ws + OFF_HFF); }
};

__device__ const double ROPE_R[16] = {
    0.15915494309189535, 0.089499401608891013, 0.050329212104487035, 0.028302195830623399, 0.015915494309189534, 0.0089499401608891024, 0.0050329212104487037, 0.0028302195830623399,
    0.0015915494309189536, 0.00089499401608891024, 0.00050329212104487033, 0.00028302195830623395, 0.00015915494309189535, 8.9499401608891018e-05, 5.0329212104487035e-05, 2.8302195830623396e-05};

__device__ __forceinline__ unsigned pk2(float lo, float hi) { return pg8::cvt_pk_bf16(lo, hi); }
__device__ __forceinline__ void st_bf16x8(bf16_t* p, f32x4 a, f32x4 b) { u32x4 w; w.x = pk2(a[0], a[1]); w.y = pk2(a[2], a[3]); w.z = pk2(b[0], b[1]); w.w = pk2(b[2], b[3]); *(u32x4*)p = w; }
__device__ __forceinline__ void ld_bf16x8(const bf16_t* p, f32x4& a, f32x4& b) { const u32x4 w = *(const u32x4*)p;
    a = (f32x4){__uint_as_float(w.x << 16), __uint_as_float(w.x & 0xffff0000u), __uint_as_float(w.y << 16), __uint_as_float(w.y & 0xffff0000u)};
    b = (f32x4){__uint_as_float(w.z << 16), __uint_as_float(w.z & 0xffff0000u), __uint_as_float(w.w << 16), __uint_as_float(w.w & 0xffff0000u)}; }
__device__ __forceinline__ float dot4(f32x4 a) { return (a[0] * a[0] + a[1] * a[1]) + (a[2] * a[2] + a[3] * a[3]); }
__device__ __forceinline__ float sum4(f32x4 a) { return (a[0] + a[1]) + (a[2] + a[3]); }
__device__ __forceinline__ int batch_of(int row) { return row < TP ? (row >> 13) : 8 + ((row - TP) >> 5); }
__device__ __forceinline__ int pos_of(int row) { return row < TP ? (row & 8191) : PAST + ((row - TP) & 31); }
__device__ __forceinline__ int latrow_of(int row) { return row < TP ? row : TP + ((row - TP) >> 5) * TKS + PAST + ((row - TP) & 31); }
__device__ __forceinline__ void rope_cs(int pos, int i, float& c, float& s) {
    double t = (double)pos * ROPE_R[i]; t -= floor(t); const float tf = (float)t;
    c = __builtin_amdgcn_cosf(tf); s = __builtin_amdgcn_sinf(tf);
}
__device__ __forceinline__ float silu_f(float x) { return x * __builtin_amdgcn_rcpf(1.0f + __builtin_amdgcn_exp2f(-1.4426950408889634f * x)); }
__device__ __forceinline__ float rs_of_latrow(const Ctx& C, int L) {
    int tok;
    if (L < TP) tok = L;
    else { const int s = L - TP, b = s / TKS, t = s - b * TKS; if (t < PAST) return 1.0f; tok = TP + b * 32 + (t - PAST); }
    const f32x4 v = *(const f32x4*)(C.ssq_kv() + (unsigned)tok * 4);
    return rsqrtf(sum4(v) * (1.0f / 256.0f) + EPS);
}


__device__ __forceinline__ void row_stats8(const float* part, int row0, int fq, float inv_n, float (&rs)[8]) {
    f32x4 sp[8];
#pragma unroll
    for (int i = 0; i < 8; ++i) sp[i] = *(const f32x4*)(part + (unsigned)(row0 + (i >> 2) * 128 + (i & 3) * 16) * 16 + fq * 4);
#pragma unroll
    for (int i = 0; i < 8; ++i) { float s = sum4(sp[i]); s += __shfl_xor(s, 16); s += __shfl_xor(s, 32); rs[i] = rsqrtf(s * inv_n + EPS); }
}

struct EpiAll {
    static constexpr bool PERM = true, AFTER_DRAIN = false;
    const Ctx& C; int mode;
    __device__ __forceinline__ void operator()(const f32x4 (&acc)[2][2][4][2], const pg8::Unit& u, int wr_, int wc_, int fr_, int fq_) const {
        int wr = wr_, wc = wc_, fr = fr_, fq = fq_;
        asm volatile("" : "+s"(wr), "+s"(wc), "+v"(fr), "+v"(fq));
        const int row0 = u.pm * 256 + wr * 64 + fr, colw = wc * 32 + fq * 8, pn = u.pn;
        if (mode == 0) {
            if (pn < 4) {
                const bool isq = pn < 3;
                const float* gsrc = isq ? C.p.q_norm_g + pn * 256 : C.p.kv_norm_g;
                f32x4 g[2][2];
#pragma unroll
                for (int bj = 0; bj < 2; ++bj)
#pragma unroll
                    for (int n = 0; n < 2; ++n) g[bj][n] = *(const f32x4*)(gsrc + bj * 128 + colw + n * 4);
#pragma unroll
                for (int ai = 0; ai < 2; ++ai)
#pragma unroll
                    for (int m = 0; m < 4; ++m) {
                        const int row = row0 + ai * 128 + m * 16; float s = 0.f;
#pragma unroll
                        for (int bj = 0; bj < 2; ++bj) {
                            const f32x4 v0 = acc[ai][bj][m][0], v1 = acc[ai][bj][m][1]; s += dot4(v0) + dot4(v1);
                            bf16_t* dst;
                            if (isq) dst = C.cq() + (unsigned)row * 768 + pn * 256 + bj * 128 + colw;
                            else {
                                dst = C.lat() + (unsigned)latrow_of(row) * 256 + bj * 128 + colw;
                            }
                            st_bf16x8(dst, v0 * g[bj][0], v1 * g[bj][1]);
                        }
                        s += __shfl_xor(s, 16); s += __shfl_xor(s, 32);
                        if (fq == 0) { if (isq) { C.ssq_q()[(unsigned)row * 16 + pn * 4 + wc] = s; if (pn == 0) C.ssq_q()[(unsigned)row * 16 + 12 + wc] = 0.f; } else C.ssq_kv()[(unsigned)row * 4 + wc] = s; }
                    }
            } else if (pn < 8) {
                const int col = (pn - 4) * 128 + colw;
#pragma unroll
                for (int ai = 0; ai < 2; ++ai)
#pragma unroll
                    for (int m = 0; m < 4; ++m) {
                        const int row = row0 + ai * 128 + m * 16;
                        const f32x4 g0 = acc[ai][0][m][0] * acc[ai][1][m][0], g1 = acc[ai][0][m][1] * acc[ai][1][m][1];
                        st_bf16x8(C.gi() + (unsigned)row * 512 + col, g0, g1);
                        if (row < TP) { const int tt = row & 8191; if (tt >= 8190) { float* o = C.p.out + OCP + (unsigned)((row >> 13) * 2 + (tt - 8190)) * 512 + col; *(f32x4*)o = g0; *(f32x4*)(o + 4) = g1; } }
                        else { const int s = row - TP, tt = s & 31; if (tt >= 30) { float* o = C.p.out + OCS + (unsigned)((s >> 5) * 2 + (tt - 30)) * 512 + col; *(f32x4*)o = g0; *(f32x4*)(o + 4) = g1; } }
                    }
            } else if (pn < 10) {
#pragma unroll
                for (int ai = 0; ai < 2; ++ai)
#pragma unroll
                    for (int m = 0; m < 4; ++m) {
                        const int row = row0 + ai * 128 + m * 16;
#pragma unroll
                        for (int bj = 0; bj < 2; ++bj) st_bf16x8(C.gb() + (unsigned)row * 512 + (pn - 8) * 256 + bj * 128 + colw, acc[ai][bj][m][0], acc[ai][bj][m][1]);
                    }
            } else {
                if (wc == 0 && fq < 2) {
#pragma unroll
                    for (int ai = 0; ai < 2; ++ai)
#pragma unroll
                        for (int m = 0; m < 4; ++m) {
                            const int row = row0 + ai * 128 + m * 16, pos = pos_of(row);
                            f32x4 y1[2], y2[2];
#pragma unroll
                            for (int n = 0; n < 2; ++n)
#pragma unroll
                                for (int e = 0; e < 4; ++e) {
                                    float c, s; rope_cs(pos, fq * 8 + n * 4 + e, c, s);
                                    const float x1 = acc[ai][0][m][n][e], x2 = acc[ai][1][m][n][e];
                                    y1[n][e] = x1 * c - x2 * s; y2[n][e] = x1 * s + x2 * c;
                                }
                            float* o = C.p.out + (row < TP ? OKP + (unsigned)row * 32 : OKS + (unsigned)(row - TP) * 32) + fq * 8;
                            *(f32x4*)o = y1[0]; *(f32x4*)(o + 4) = y1[1]; *(f32x4*)(o + 16) = y2[0]; *(f32x4*)(o + 20) = y2[1];
                            bf16_t* kb = C.krb() + (unsigned)latrow_of(row) * 32 + fq * 8;
                            st_bf16x8(kb, y1[0], y1[1]); st_bf16x8(kb + 16, y2[0], y2[1]);
                        }
                }
            }
        } else if (mode == 1) {
            float rqv[8]; row_stats8(C.ssq_q(), row0, fq, 1.0f / 768.0f, rqv);
#pragma unroll
            for (int ai = 0; ai < 2; ++ai)
#pragma unroll
                for (int m = 0; m < 4; ++m) {
                    const int row = row0 + ai * 128 + m * 16;
                    const float rq = rqv[ai * 4 + m] * QSCALE;
                    if (pn < 2) {
#pragma unroll
                        for (int bj = 0; bj < 2; ++bj) st_bf16x8(C.Qn() + (unsigned)row * 512 + pn * 256 + bj * 128 + colw, acc[ai][bj][m][0] * rq, acc[ai][bj][m][1] * rq);
                    } else {
                        const int pos = pos_of(row), sel = fq & 1;
                        f32x4 y1[2], y2[2];
#pragma unroll
                        for (int n = 0; n < 2; ++n)
#pragma unroll
                            for (int e = 0; e < 4; ++e) {
                                float c, s; rope_cs(pos, sel * 8 + n * 4 + e, c, s);
                                const float x1 = acc[ai][0][m][n][e] * rq, x2 = acc[ai][1][m][n][e] * rq;
                                y1[n][e] = x1 * c - x2 * s; y2[n][e] = x1 * s + x2 * c;
                            }
                        bf16_t* q = C.Qr() + (unsigned)row * 256 + colw;
                        st_bf16x8(q, y1[0], y1[1]); st_bf16x8(q + 128, y2[0], y2[1]);
                    }
                }
        } else if (mode == 2) {
            f32x4 sv[8]; bool past[8];
#pragma unroll
            for (int i = 0; i < 8; ++i) {
                const int L = row0 + (i >> 2) * 128 + (i & 3) * 16; int tok = L; past[i] = false;
                if (L >= TP) { const int s = L - TP, bb = s / TKS, t = s - bb * TKS; past[i] = t < PAST; tok = past[i] ? 0 : TP + bb * 32 + (t - PAST); }
                sv[i] = *(const f32x4*)(C.ssq_kv() + (unsigned)tok * 4);
            }
#pragma unroll
            for (int ai = 0; ai < 2; ++ai)
#pragma unroll
                for (int m = 0; m < 4; ++m) {
                    const int row = row0 + ai * 128 + m * 16, i = ai * 4 + m;
                    const float rs = past[i] ? 1.0f : rsqrtf(sum4(sv[i]) * (1.0f / 256.0f) + EPS);
#pragma unroll
                    for (int bj = 0; bj < 2; ++bj) st_bf16x8(C.Kn() + (unsigned)row * 512 + pn * 256 + bj * 128 + colw, acc[ai][bj][m][0] * rs, acc[ai][bj][m][1] * rs);
                }
        } else if (mode == 3) {
            f32x4 rs[2][2];
#pragma unroll
            for (int bj = 0; bj < 2; ++bj) {
                f32x4 sv[8]; bool past[8];
#pragma unroll
                for (int i = 0; i < 8; ++i) {
                    const int L = pn * 256 + bj * 128 + colw + i; int tok = L; past[i] = false;
                    if (L >= TP) { const int s = L - TP, bb = s / TKS, t = s - bb * TKS; past[i] = t < PAST; tok = past[i] ? 0 : TP + bb * 32 + (t - PAST); }
                    sv[i] = *(const f32x4*)(C.ssq_kv() + (unsigned)tok * 4);
                }
#pragma unroll
                for (int i = 0; i < 8; ++i) rs[bj][i >> 2][i & 3] = past[i] ? 1.0f : rsqrtf(sum4(sv[i]) * (1.0f / 256.0f) + EPS);
            }
#pragma unroll
            for (int ai = 0; ai < 2; ++ai)
#pragma unroll
                for (int m = 0; m < 4; ++m) {
                    const int row = row0 + ai * 128 + m * 16;
#pragma unroll
                    for (int bj = 0; bj < 2; ++bj) st_bf16x8(C.Vt() + (unsigned)row * LV + pn * 256 + bj * 128 + colw, acc[ai][bj][m][0] * rs[bj][0], acc[ai][bj][m][1] * rs[bj][1]);
                }
        } else if (mode == 4) {
            if (u.pm * 256 < TP) {
                const float* mb = C.mod() + (unsigned)(u.pm >> 5) * 6144;
                f32x4 g1h[2][2], gkh[2][2];
#pragma unroll
                for (int bj = 0; bj < 2; ++bj)
#pragma unroll
                    for (int n = 0; n < 2; ++n) { const int c4 = pn * 256 + bj * 128 + colw + n * 4;
                        g1h[bj][n] = *(const f32x4*)(mb + 2048 + c4); gkh[bj][n] = *(const f32x4*)(C.p.norm_ffn_g + c4) * (*(const f32x4*)(mb + 4096 + c4) + 1.0f); }
#pragma unroll
                for (int ai = 0; ai < 2; ++ai)
#pragma unroll
                    for (int mp = 0; mp < 2; ++mp) {
                        f32x4 xv[2][2][2];
#pragma unroll
                        for (int mm = 0; mm < 2; ++mm) { const float* xr = C.p.x_p + (unsigned)(row0 + ai * 128 + (mp * 2 + mm) * 16) * DM + pn * 256 + colw;
#pragma unroll
                            for (int bj = 0; bj < 2; ++bj) { xv[mm][bj][0] = *(const f32x4*)(xr + bj * 128); xv[mm][bj][1] = *(const f32x4*)(xr + bj * 128 + 4); } }
#pragma unroll
                        for (int mm = 0; mm < 2; ++mm) { const int m = mp * 2 + mm, row = row0 + ai * 128 + m * 16; float s = 0.f;
#pragma unroll
                            for (int bj = 0; bj < 2; ++bj) { const int col = pn * 256 + bj * 128 + colw;
                                const f32x4 xa = xv[mm][bj][0] + g1h[bj][0] * acc[ai][bj][m][0], xb = xv[mm][bj][1] + g1h[bj][1] * acc[ai][bj][m][1];
                                st_bf16x8(C.xb() + (unsigned)row * DM + col, xa, xb); s += dot4(xa) + dot4(xb);
                                st_bf16x8(C.A2() + (unsigned)row * DM + col, xa * gkh[bj][0], xb * gkh[bj][1]); }
                            s += __shfl_xor(s, 16); s += __shfl_xor(s, 32);
                            if (fq == 0) C.ssq_x1()[(unsigned)row * 16 + pn * 4 + wc] = s; }
                        asm volatile("" ::: "memory");
                    }
            } else {
#pragma unroll
            for (int ai = 0; ai < 2; ++ai)
#pragma unroll
                for (int m = 0; m < 4; ++m) {
                    const int row = row0 + ai * 128 + m * 16, b = batch_of(row);
                    const float* xr = row < TP ? C.p.x_p + (unsigned)row * DM : C.p.x_s + (unsigned)(row - TP) * DM;
                    const float* mb = C.mod() + (unsigned)b * 6144; float s = 0.f;
#pragma unroll
                    for (int bj = 0; bj < 2; ++bj) {
                        const int col = pn * 256 + bj * 128 + colw; f32x4 a2[2], xk[2];
#pragma unroll
                        for (int n = 0; n < 2; ++n) {
                            const int c4 = col + n * 4;
                            const f32x4 xv = *(const f32x4*)(xr + c4), g1 = *(const f32x4*)(mb + 2048 + c4), sc2 = *(const f32x4*)(mb + 4096 + c4), gn = *(const f32x4*)(C.p.norm_ffn_g + c4);
                            const f32x4 x1 = xv + g1 * acc[ai][bj][m][n];
                            xk[n] = x1; s += dot4(x1);
                            a2[n] = x1 * gn * (sc2 + 1.0f);
                        }
                        st_bf16x8(C.xb() + (unsigned)row * DM + col, xk[0], xk[1]);
                        st_bf16x8(C.A2() + (unsigned)row * DM + col, a2[0], a2[1]);
                    }
                    s += __shfl_xor(s, 16); s += __shfl_xor(s, 32);
                    if (fq == 0) C.ssq_x1()[(unsigned)row * 16 + pn * 4 + wc] = s;
                }
            }
        } else if (mode == 5) {
            const int colg = pn * 128 + colw;
            float rsv[8]; row_stats8(C.ssq_x1(), row0, fq, 1.0f / 1024.0f, rsv);
            if (u.pm * 256 < TP) {
                f32x4 bgh[2], buh[2];
                { const size_t bo = (unsigned)(u.pm >> 5) * DFF + colg;
#pragma unroll
                  for (int n = 0; n < 2; ++n) { bgh[n] = *(const f32x4*)(C.bg() + bo + n * 4); buh[n] = *(const f32x4*)(C.bu() + bo + n * 4); } }
#pragma unroll
                for (int ai = 0; ai < 2; ++ai)
#pragma unroll
                    for (int m = 0; m < 4; ++m) {
                        const int row = row0 + ai * 128 + m * 16; const float rstd = rsv[ai * 4 + m]; f32x4 hv[2];
#pragma unroll
                        for (int n = 0; n < 2; ++n) {
                            const f32x4 gate = acc[ai][0][m][n] * rstd + bgh[n], up = acc[ai][1][m][n] * rstd + buh[n];
#pragma unroll
                            for (int e = 0; e < 4; ++e) hv[n][e] = silu_f(gate[e]) * up[e];
                        }
                        st_bf16x8(C.hff() + (unsigned)row * DFF + colg, hv[0], hv[1]);
                    }
            } else {
#pragma unroll
                for (int ai = 0; ai < 2; ++ai)
#pragma unroll
                    for (int m = 0; m < 4; ++m) {
                        const int row = row0 + ai * 128 + m * 16; const float rstd = rsv[ai * 4 + m]; f32x4 hv[2];
                        const size_t bo = (unsigned)batch_of(row) * DFF + colg;
#pragma unroll
                        for (int n = 0; n < 2; ++n) {
                            const f32x4 gate = acc[ai][0][m][n] * rstd + *(const f32x4*)(C.bg() + bo + n * 4), up = acc[ai][1][m][n] * rstd + *(const f32x4*)(C.bu() + bo + n * 4);
#pragma unroll
                            for (int e = 0; e < 4; ++e) hv[n][e] = silu_f(gate[e]) * up[e];
                        }
                        st_bf16x8(C.hff() + (unsigned)row * DFF + colg, hv[0], hv[1]);
                    }
            }
        } else if (mode == 6) {
            if (u.pm * 256 < TP) {
                const float* mb = C.mod() + (unsigned)(u.pm >> 5) * 6144 + 5120 + pn * 256 + colw;
                const f32x4 g2a0 = *(const f32x4*)mb, g2b0 = *(const f32x4*)(mb + 4), g2a1 = *(const f32x4*)(mb + 128), g2b1 = *(const f32x4*)(mb + 132);
#pragma unroll
                for (int ai = 0; ai < 2; ++ai) {
                    u32x4 xw[4][2];
#pragma unroll
                    for (int m = 0; m < 4; ++m) { const bf16_t* xr = C.xb() + (unsigned)(row0 + ai * 128 + m * 16) * DM + pn * 256 + colw; xw[m][0] = *(const u32x4*)xr; xw[m][1] = *(const u32x4*)(xr + 128); }
#pragma unroll
                    for (int m = 0; m < 4; ++m) { bf16_t* xr = C.xb() + (unsigned)(row0 + ai * 128 + m * 16) * DM + pn * 256 + colw;
#pragma unroll
                        for (int bj = 0; bj < 2; ++bj) { const u32x4 w = xw[m][bj];
                            const f32x4 xa = (f32x4){__uint_as_float(w.x << 16), __uint_as_float(w.x & 0xffff0000u), __uint_as_float(w.y << 16), __uint_as_float(w.y & 0xffff0000u)};
                            const f32x4 xc = (f32x4){__uint_as_float(w.z << 16), __uint_as_float(w.z & 0xffff0000u), __uint_as_float(w.w << 16), __uint_as_float(w.w & 0xffff0000u)};
                            st_bf16x8(xr + bj * 128, xa + (bj ? g2a1 : g2a0) * acc[ai][bj][m][0], xc + (bj ? g2b1 : g2b0) * acc[ai][bj][m][1]); } }
                    asm volatile("" ::: "memory");
                }
            } else {
#pragma unroll
                for (int ai = 0; ai < 2; ++ai)
#pragma unroll
                    for (int m = 0; m < 4; ++m) {
                        const int row = row0 + ai * 128 + m * 16;
                        const float* mb = C.mod() + (unsigned)batch_of(row) * 6144 + 5120;
#pragma unroll
                        for (int bj = 0; bj < 2; ++bj) {
                            const int col = pn * 256 + bj * 128 + colw; bf16_t* xr = C.xb() + (unsigned)row * DM + col;
                            f32x4 xa, xc; ld_bf16x8(xr, xa, xc);
                            st_bf16x8(xr, xa + *(const f32x4*)(mb + col) * acc[ai][bj][m][0], xc + *(const f32x4*)(mb + col + 4) * acc[ai][bj][m][1]);
                        }
                    }
            }
        } else if (mode == 7) {
#pragma unroll
            for (int ai = 0; ai < 2; ++ai)
#pragma unroll
                for (int m = 0; m < 4; ++m) {
                    float* o = C.part() + ((unsigned)u.kc * 1024 + (unsigned)(row0 + ai * 128 + m * 16)) * 1024 + pn * 256 + colw;
#pragma unroll
                    for (int bj = 0; bj < 2; ++bj) { *(f32x4*)(o + bj * 128) = acc[ai][bj][m][0]; *(f32x4*)(o + bj * 128 + 4) = acc[ai][bj][m][1]; }
                }
        }
    }
};

struct WSrc { const float* W; int ld; int col; };
__device__ __forceinline__ WSrc wsrc(const Ctx& C, int mat, int n) {
    WSrc r; r.W = C.p.w_in; r.ld = 2592; r.col = -1;
    if (mat == 0) {
        if (n < 1024) r.col = n;
        else if (n < 2048) { const int j = (n - 1024) >> 8, c = (n - 1024) & 255; r.col = c < 128 ? 1056 + 128 * j + c : 2080 + 128 * j + (c - 128); }
        else if (n < 2560) r.col = 1568 + (n - 2048);
        else { const int c = n - 2560; if (c < 16) r.col = 1024 + c; else if (c >= 128 && c < 144) r.col = 1040 + (c - 128); }
    } else if (mat == 1) {
        r.W = C.p.w_uq; r.ld = 768;
        if (n < 512) r.col = (n >> 6) * 96 + (n & 63);
        else { const int c = n - 512, half = c >> 7, cc = c & 127; r.col = (cc >> 4) * 96 + 64 + half * 16 + (cc & 15); }
    } else if (mat == 2) { r.W = C.p.w_ukv; r.ld = 1024; r.col = (n >> 6) * 128 + (n & 63); }
    else if (mat == 3) { r.W = C.p.w_ukv; r.ld = 1024; r.col = (n >> 6) * 128 + 64 + (n & 63); }
    else if (mat == 4) { r.W = C.p.w_out; r.ld = 1024; r.col = n; }
    else if (mat == 5) { const int j = n >> 8, c = n & 255; r.ld = 2816; if (c < 128) { r.W = C.p.w_gate; r.col = 128 * j + c; } else { r.W = C.p.w_up; r.col = 128 * j + (c - 128); } }
    else { r.W = C.p.w_down; r.ld = 1024; r.col = n; }
    return r;
}
__device__ __forceinline__ void transpose_item(const Ctx& C, int mat, int K, bf16_t* WT, LAS float* scr, int item, int nblk, int lane_) {
    int lane = lane_; asm volatile("" : "+v"(lane));
    const int kb = item / nblk, nb = item - kb * nblk, k0 = 64 * kb, n0 = 32 * nb;
    const WSrc s = wsrc(C, mat, n0 + (lane & 31));
    float tv[32];
#pragma unroll
    for (int i = 0; i < 32; ++i) { const int kk = 2 * i + (lane >> 5); tv[i] = s.col >= 0 ? s.W[(size_t)(k0 + kk) * s.ld + s.col] : 0.f; }
#pragma unroll
    for (int i = 0; i < 32; ++i) { const int kk = 2 * i + (lane >> 5); scr[kk * 33 + (lane & 31)] = tv[i]; }
    asm volatile("s_waitcnt lgkmcnt(0)" ::: "memory");
    const int c = lane & 7;
#pragma unroll
    for (int j = 0; j < 4; ++j) { const int n = (lane >> 3) + 8 * j; const LAS float* t = scr + (8 * c) * 33 + n;
        u32x4 o; o.x = pk2(t[0 * 33], t[1 * 33]); o.y = pk2(t[2 * 33], t[3 * 33]); o.z = pk2(t[4 * 33], t[5 * 33]); o.w = pk2(t[6 * 33], t[7 * 33]);
        *(u32x4*)(WT + (size_t)(n0 + n) * K + k0 + 8 * c) = o; }
    asm volatile("s_waitcnt lgkmcnt(0)" ::: "memory");
}

template <int ACT>
__device__ __forceinline__ void gemv_item(const Ctx& C, LAS unsigned char* lds, const float* W, int ldw, int n0, const float* bias, float* outp, int ldo, int tid_, int wave, int lane_) {
    int tid = tid_, lane = lane_; asm volatile("" : "+v"(tid), "+v"(lane));
    LAS float* act = (LAS float*)lds + wave * 2560;
    float acc[40];
#pragma unroll
    for (int b = 0; b < 40; ++b) acc[b] = 0.f;
    for (int pass = 0; pass < 2; ++pass) {
        const int kbase = wave * 128 + pass * 64;
        {
            const int k = kbase + lane; float av[40];
#pragma unroll
            for (int bb = 0; bb < 40; ++bb) av[bb] = ACT == 0 ? (bb < 8 ? C.p.c_p[bb * 1024 + k] : C.p.c_s[(bb - 8) * 1024 + k]) : C.mod()[(size_t)bb * 6144 + 3072 + k];
#pragma unroll
            for (int bb = 0; bb < 40; ++bb) { float v = av[bb]; if (ACT == 0) v = v / (1.0f + __expf(-v)); act[lane * 40 + bb] = v; }
        }
        asm volatile("s_waitcnt lgkmcnt(0)" ::: "memory");
        for (int kq = 0; kq < 64; kq += 16) {
        float wv[16];
#pragma unroll
        for (int i = 0; i < 16; ++i) wv[i] = W[(size_t)(kbase + kq + i) * ldw + n0 + lane];
#pragma unroll
        for (int i = 0; i < 16; ++i) {
            const int kk = kq + i; const float w = wv[i];
#pragma unroll
            for (int b4 = 0; b4 < 10; ++b4) { const f32x4 a = *(const LAS f32x4*)(act + kk * 40 + b4 * 4);
                acc[b4 * 4 + 0] += a[0] * w; acc[b4 * 4 + 1] += a[1] * w; acc[b4 * 4 + 2] += a[2] * w; acc[b4 * 4 + 3] += a[3] * w; }
        }
        }
        asm volatile("s_waitcnt lgkmcnt(0)" ::: "memory");
    }
    __syncthreads();
    LAS float* red = (LAS float*)lds;
#pragma unroll
    for (int b = 0; b < 40; ++b) red[(wave * 40 + b) * 64 + lane] = acc[b];
    __syncthreads();
    for (int o = tid; o < 2560; o += 512) { const int b = o >> 6, l = o & 63; float s = bias ? bias[n0 + l] : 0.f;
#pragma unroll
        for (int w = 0; w < 8; ++w) s += red[(w * 40 + b) * 64 + l];
        outp[(size_t)b * ldo + n0 + l] = s; }
    __syncthreads();
}


template <int R>
__device__ __forceinline__ void h1_group(const Ctx& C, int row0, int lane) {
    const float* xr = row0 < TP ? C.p.x_p + (size_t)row0 * DM : C.p.x_s + (size_t)(row0 - TP) * DM;
    const float* mb = C.mod() + (size_t)batch_of(row0) * 6144;
    f32x4 v[R][4]; float s[R];
#pragma unroll
    for (int r = 0; r < R; ++r)
#pragma unroll
        for (int j = 0; j < 4; ++j) v[r][j] = *(const f32x4*)(xr + (size_t)r * DM + 4 * lane + 256 * j);
#pragma unroll
    for (int r = 0; r < R; ++r) s[r] = dot4(v[r][0]) + dot4(v[r][1]) + dot4(v[r][2]) + dot4(v[r][3]);
#pragma unroll
    for (int o = 1; o < 64; o <<= 1) {
#pragma unroll
        for (int r = 0; r < R; ++r) s[r] += __shfl_xor(s[r], o);
    }
#pragma unroll
    for (int r = 0; r < R; ++r) s[r] = rsqrtf(s[r] * (1.0f / 1024.0f) + EPS);
#pragma unroll
    for (int j = 0; j < 4; ++j) {
        const int k = 4 * lane + 256 * j;
        const f32x4 g = *(const f32x4*)(C.p.norm_mix_g + k), sh = *(const f32x4*)(mb + k), sc = *(const f32x4*)(mb + 1024 + k);
        const f32x4 gs = g * (sc + 1.0f);
#pragma unroll
        for (int r = 0; r < R; ++r) {
            const f32x4 hv = v[r][j] * s[r] * gs + sh;
            u32x2 w; w.x = pk2(hv[0], hv[1]); w.y = pk2(hv[2], hv[3]);
            *(u32x2*)(C.h1() + (size_t)(row0 + r) * DM + k) = w;
        }
    }
}

constexpr int KSTR = 208, VSTR = 144, KBYTES = 64 * KSTR, VBYTES = 64 * VSTR, ATB = KBYTES + VBYTES;
#define ATT_THR 40.0f
__device__ __forceinline__ bf16x8 pack8(const f32x16& p, int b) {
    u32x4 w; w.x = pk2(p[b], p[b + 1]); w.y = pk2(p[b + 2], p[b + 3]); w.z = pk2(p[b + 4], p[b + 5]); w.w = pk2(p[b + 6], p[b + 7]); return __builtin_bit_cast(bf16x8, w);
}
__device__ __forceinline__ float xmax32(float x) {
    auto rr = __builtin_amdgcn_permlane32_swap(__float_as_uint(x), __float_as_uint(x), false, false);
    return fmaxf(__uint_as_float(rr[0]), __uint_as_float(rr[1]));
}
__device__ __forceinline__ float xsum32(float x) {
    auto rr = __builtin_amdgcn_permlane32_swap(__float_as_uint(x), __float_as_uint(x), false, false);
    return __uint_as_float(rr[0]) + __uint_as_float(rr[1]);
}
#define ASB() __builtin_amdgcn_sched_barrier(0)
#if defined(PROBE_NOBAR)
#define ATT_BAR() do { if (!nomem) __syncthreads(); } while (0)
#else
#define ATT_BAR() __syncthreads()
#endif
__device__ __forceinline__ float max3f(float a, float b, float c) { float r; asm("v_max3_f32 %0, %1, %2, %3" : "=v"(r) : "v"(a), "v"(b), "v"(c)); return r; }
__device__ __forceinline__ void attn_unit(const Ctx& C, LAS unsigned char* lds, int kvbase, int NT, int wlim, bool half_last, int qrow, int h, int tid, int lane, bool nomem) {
    const int i32 = lane & 31, hi = lane >> 5;
    const int pi = (((i32 >> 2) & 1) << 4) | ((i32 >> 3) << 2) | (i32 & 3);
    const bool active = wlim >= 0;
    bf16x8 qf[6];
#pragma unroll
    for (int kb = 0; kb < 6; ++kb) qf[kb] = (bf16x8){0, 0, 0, 0, 0, 0, 0, 0};
    if (active) {
        const bf16_t* qn = C.Qn() + (size_t)qrow * 512 + h * 64 + hi * 8;
#pragma unroll
        for (int kb = 0; kb < 4; ++kb) qf[kb] = *(const bf16x8*)(qn + kb * 16);
        const bf16_t* qr = C.Qr() + (size_t)qrow * 256 + h * 16 + hi * 8;
        qf[4] = *(const bf16x8*)qr; qf[5] = *(const bf16x8*)(qr + 128);
    }
    f32x16 o0, o1, oL;
#pragma unroll
    for (int r = 0; r < 16; ++r) { o0[r] = 0.f; o1[r] = 0.f; oL[r] = 0.f; }
    float mref = 0.f, lrun = 0.f; bool shifted = false;
    const bf16x8 ones = (bf16x8){0x3F80, 0x3F80, 0x3F80, 0x3F80, 0x3F80, 0x3F80, 0x3F80, 0x3F80};
    const int sr = tid >> 3, sc = tid & 7;
    const bf16_t* gKn = C.Kn() + (size_t)(kvbase + sr) * 512 + h * 64 + sc * 8;
    const bf16_t* gKr = C.krb() + (size_t)(kvbase + (tid >> 2)) * 32 + (tid & 3) * 8;
    const bf16_t* gV = C.Vt() + (size_t)(h * 64 + sr) * LV + kvbase + sc * 8;
    const unsigned dK = sr * KSTR + sc * 16, dKr = (tid >> 2) * KSTR + 128 + (tid & 3) * 16, dV = KBYTES + sr * VSTR + sc * 16;
    const bool do_kr = tid < 256;
    u32x4 rk, rkr = (u32x4){0, 0, 0, 0}, rv;
#define ATT_LOAD(j) do { rk = *(const u32x4*)(gKn + (size_t)(j) * 64 * 512); if (do_kr) rkr = *(const u32x4*)(gKr + (size_t)(j) * 64 * 32); rv = *(const u32x4*)(gV + (size_t)(j) * 64); } while (0)
#define ATT_STORE(slot) do { LAS unsigned char* bb_ = lds + (slot) * ATB; *(LAS u32x4*)(bb_ + dK) = rk; if (do_kr) *(LAS u32x4*)(bb_ + dKr) = rkr; *(LAS u32x4*)(bb_ + dV) = rv; } while (0)
    ATT_LOAD(0); ATT_STORE(0);
    if (NT > 1) { ATT_LOAD(1); ATT_STORE(1); }
    __syncthreads();
    const unsigned kfo = pi * KSTR + hi * 16, vfo = KBYTES + pi * VSTR + hi * 32;
    f32x16 sA0, sA1, sB0, sB1;
    bf16x8 pb[4];
#pragma unroll
    for (int c = 0; c < 4; ++c) pb[c] = (bf16x8){0, 0, 0, 0, 0, 0, 0, 0};
    if (active) {
        const LAS unsigned char* ka = lds + kfo;
#pragma unroll
        for (int kb = 0; kb < 6; ++kb) {
            const bf16x8 k0 = *(const LAS bf16x8*)(ka + kb * 32), k1 = *(const LAS bf16x8*)(ka + 32 * KSTR + kb * 32);
            sA0 = __builtin_amdgcn_mfma_f32_32x32x16_bf16(k0, qf[kb], kb == 0 ? oL : sA0, 0, 0, 0);
            sA1 = __builtin_amdgcn_mfma_f32_32x32x16_bf16(k1, qf[kb], kb == 0 ? oL : sA1, 0, 0, 0);
        }
    }
#define ATT_VF_LO(va) do { vf[0] = *(const LAS bf16x8*)(va); vf[1] = *(const LAS bf16x8*)((va) + 32 * VSTR); vf[2] = *(const LAS bf16x8*)((va) + 16); vf[3] = *(const LAS bf16x8*)((va) + 32 * VSTR + 16); } while (0)
#define ATT_VF_HI(va) do { vf[0] = *(const LAS bf16x8*)((va) + 64); vf[1] = *(const LAS bf16x8*)((va) + 32 * VSTR + 64); vf[2] = *(const LAS bf16x8*)((va) + 80); vf[3] = *(const LAS bf16x8*)((va) + 32 * VSTR + 80); } while (0)
#define ATT_PVMMA(i) do { if ((i) & 1) o1 = __builtin_amdgcn_mfma_f32_32x32x16_bf16(vf[(i) & 3], pb[(i) >> 1], o1, 0, 0, 0); else o0 = __builtin_amdgcn_mfma_f32_32x32x16_bf16(vf[(i) & 3], pb[(i) >> 1], o0, 0, 0, 0); } while (0)
#define ATT_EXP4(SA0, SA1, i) do { if ((i) < 4) { _Pragma("unroll") for (int r = 4 * (i); r < 4 * (i) + 4; ++r) SA0[r] = __builtin_amdgcn_exp2f(SA0[r]); asm volatile("" : "+v"(SA0)); } \
                                   else { _Pragma("unroll") for (int r = 4 * ((i) - 4); r < 4 * ((i) - 4) + 4; ++r) SA1[r] = __builtin_amdgcn_exp2f(SA1[r]); asm volatile("" : "+v"(SA1)); } } while (0)
#define ATT_EXP2(SA0, SA1, j) do { if ((j) < 8) { SA0[2 * (j)] = __builtin_amdgcn_exp2f(SA0[2 * (j)]); SA0[2 * (j) + 1] = __builtin_amdgcn_exp2f(SA0[2 * (j) + 1]); asm volatile("" : "+v"(SA0)); } \
                                   else { SA1[2 * ((j) - 8)] = __builtin_amdgcn_exp2f(SA1[2 * ((j) - 8)]); SA1[2 * ((j) - 8) + 1] = __builtin_amdgcn_exp2f(SA1[2 * ((j) - 8) + 1]); asm volatile("" : "+v"(SA1)); } } while (0)
#define ATT_MAXUPD(SA0, SA1, t_) \
    if (half_last && (t_) == NT - 1) { asm volatile("" ::: "memory"); _Pragma("unroll") for (int r = 0; r < 16; ++r) SA1[r] = -INFINITY; } \
    float mxa = max3f(SA0[0], SA0[1], SA0[2]), mxb = max3f(SA0[4], SA0[5], SA0[6]), mxc = max3f(SA1[0], SA1[1], SA1[2]), mxd = max3f(SA1[4], SA1[5], SA1[6]); \
    mxa = max3f(mxa, SA0[3], SA0[8]); mxb = max3f(mxb, SA0[7], SA0[9]); mxc = max3f(mxc, SA1[3], SA1[8]); mxd = max3f(mxd, SA1[7], SA1[9]); \
    mxa = max3f(mxa, SA0[10], SA0[11]); mxb = max3f(mxb, SA0[12], SA0[13]); mxc = max3f(mxc, SA1[10], SA1[11]); mxd = max3f(mxd, SA1[12], SA1[13]); \
    mxa = max3f(mxa, SA0[14], SA0[15]); mxc = max3f(mxc, SA1[14], SA1[15]); \
    float mx = max3f(mxa, mxb, mxc); mx = fmaxf(mx, mxd); \
    mx = xmax32(mx); \
    const bool upd = __any(mx > ATT_THR || ((t_) == 0 && mx < -ATT_THR)); float alpha = 1.0f; \
    if (upd) { const float delta = (mx > ATT_THR || ((t_) == 0 && mx < -ATT_THR)) ? mx : 0.f; mref += delta; alpha = __builtin_amdgcn_exp2f(-delta); shifted = true; \
        _Pragma("unroll") for (int r = 0; r < 16; ++r) { SA0[r] -= delta; SA1[r] -= delta; } }
#define ATT_QK_SUM(SA0, SA1, SB0, SB1, t_, TAILEXP) do { const LAS unsigned char* ka = lds + (((t_) + 1) & 3) * ATB + kfo; \
      bf16x8 kf[4]; kf[0] = *(const LAS bf16x8*)(ka); kf[1] = *(const LAS bf16x8*)(ka + 32 * KSTR); kf[2] = *(const LAS bf16x8*)(ka + 32); kf[3] = *(const LAS bf16x8*)(ka + 32 * KSTR + 32); \
      _Pragma("unroll") for (int kb = 0; kb < 6; ++kb) { const int s_ = (kb & 1) * 2; \
        if (kb == 0) { if (shifted) { f32x16 cinit; { const float nm = -mref; _Pragma("unroll") for (int r = 0; r < 16; ++r) cinit[r] = nm; } \
                SB0 = __builtin_amdgcn_mfma_f32_32x32x16_bf16(kf[0], qf[0], cinit, 0, 0, 0); SB1 = __builtin_amdgcn_mfma_f32_32x32x16_bf16(kf[1], qf[0], cinit, 0, 0, 0); } \
            else { const f32x16 z16 = {0.f, 0.f, 0.f, 0.f, 0.f, 0.f, 0.f, 0.f, 0.f, 0.f, 0.f, 0.f, 0.f, 0.f, 0.f, 0.f}; \
                SB0 = __builtin_amdgcn_mfma_f32_32x32x16_bf16(kf[0], qf[0], z16, 0, 0, 0); SB1 = __builtin_amdgcn_mfma_f32_32x32x16_bf16(kf[1], qf[0], z16, 0, 0, 0); } \
            if (TAILEXP) { ATT_EXP2(SA0, SA1, 12); ATT_EXP2(SA0, SA1, 13); } } \
        else { SB0 = __builtin_amdgcn_mfma_f32_32x32x16_bf16(kf[s_], qf[kb], SB0, 0, 0, 0); \
               if (TAILEXP && kb == 1) ATT_EXP2(SA0, SA1, 14); \
               SB1 = __builtin_amdgcn_mfma_f32_32x32x16_bf16(kf[s_ + 1], qf[kb], SB1, 0, 0, 0); \
               if (TAILEXP && kb == 1) ATT_EXP2(SA0, SA1, 15); } \
        if (kb + 2 < 6) { kf[s_] = *(const LAS bf16x8*)(ka + (kb + 2) * 32); kf[s_ + 1] = *(const LAS bf16x8*)(ka + 32 * KSTR + (kb + 2) * 32); } \
        if (kb >= 1 && kb < 5) { const int c_ = kb - 1; if (c_ < 2) { pb[c_] = pack8(SA0, (c_ & 1) * 8); _Pragma("unroll") for (int r = (c_ & 1) * 8; r < (c_ & 1) * 8 + 8; ++r) lrun += SA0[r]; } else { pb[c_] = pack8(SA1, (c_ & 1) * 8); _Pragma("unroll") for (int r = (c_ & 1) * 8; r < (c_ & 1) * 8 + 8; ++r) lrun += SA1[r]; } } \
        ASB(); } \
      } while (0)
#define ATT_FIRST(SA0, SA1, SB0, SB1) do { const bool ld2 = 2 < NT && !nomem; if (ld2) ATT_LOAD(2); \
    { ATT_MAXUPD(SA0, SA1, 0) (void)alpha; } \
    _Pragma("unroll") for (int i = 0; i < 8; ++i) ATT_EXP4(SA0, SA1, i); \
    ATT_BAR(); if (ld2) ATT_STORE(2); \
    ATT_QK_SUM(SA0, SA1, SB0, SB1, 0, false); ATT_BAR(); } while (0)
#define ATT_FULL(SA0, SA1, SB0, SB1, t) do { const int t_ = (t); const bool ld2 = t_ + 2 < NT && !nomem; if (ld2) ATT_LOAD(t_ + 2); \
    bf16x8 vf[4]; const LAS unsigned char* va = lds + ((t_ + 3) & 3) * ATB + vfo; ATT_VF_LO(va); \
    ATT_MAXUPD(SA0, SA1, t_) \
    ASB(); \
    _Pragma("unroll") for (int i = 0; i < 8; ++i) { ATT_PVMMA(i); if (i < 4) vf[i] = *(const LAS bf16x8*)((va) + 64 + (i >> 1) * 16 + (i & 1) * 32 * VSTR); ATT_EXP2(SA0, SA1, i + (i >> 1)); ASB(); \
        if (i & 1) { ATT_EXP2(SA0, SA1, i + (i >> 1) + 1); ASB(); } } \
    if (upd) { lrun *= alpha; _Pragma("unroll") for (int r = 0; r < 16; ++r) { o0[r] *= alpha; o1[r] *= alpha; } } \
    ATT_BAR(); if (ld2) ATT_STORE((t_ + 2) & 3); \
    ATT_QK_SUM(SA0, SA1, SB0, SB1, t_, true); ATT_BAR(); } while (0)
#define ATT_LAST(t) do { const int t_ = (t); const bool ld2 = t_ + 2 < NT && !nomem; if (ld2) ATT_LOAD(t_ + 2); \
    bf16x8 vf[4]; const LAS unsigned char* va = lds + ((t_ + 3) & 3) * ATB + vfo; ATT_VF_LO(va); \
    _Pragma("unroll") for (int i = 0; i < 8; ++i) { ATT_PVMMA(i); if (i < 4) vf[i] = *(const LAS bf16x8*)((va) + 64 + (i >> 1) * 16 + (i & 1) * 32 * VSTR); } \
    ATT_BAR(); if (ld2) ATT_STORE((t_ + 2) & 3); ATT_BAR(); } while (0)
#define ATT_IDLE(t) do { const int t_ = (t); const bool ld2 = t_ + 2 < NT && !nomem; if (ld2) ATT_LOAD(t_ + 2); ATT_BAR(); if (ld2) ATT_STORE((t_ + 2) & 3); ATT_BAR(); } while (0)
    const bool grpB = tid >= 256;
    if (grpB) __syncthreads();
    int t = 0;
    if (active) {
        ATT_FIRST(sA0, sA1, sB0, sB1); t = 1;
        while (t <= wlim) {
            ATT_FULL(sB0, sB1, sA0, sA1, t); ++t;
            if (t > wlim) break;
            ATT_FULL(sA0, sA1, sB0, sB1, t); ++t;
        }
        ATT_LAST(t); ++t;
    }
    for (; t <= NT; ++t) ATT_IDLE(t);
    if (!grpB) __syncthreads();
    __syncthreads();
    if (active && !nomem) {
        const float inv = 1.0f / xsum32(lrun);
        bf16_t* op = C.mix() + (size_t)qrow * DM + h * 64 + hi * 16;
        f32x4 a, b;
        a = (f32x4){o0[0], o0[1], o0[2], o0[3]} * inv; b = (f32x4){o0[4], o0[5], o0[6], o0[7]} * inv; st_bf16x8(op, a, b);
        a = (f32x4){o0[8], o0[9], o0[10], o0[11]} * inv; b = (f32x4){o0[12], o0[13], o0[14], o0[15]} * inv; st_bf16x8(op + 8, a, b);
        a = (f32x4){o1[0], o1[1], o1[2], o1[3]} * inv; b = (f32x4){o1[4], o1[5], o1[6], o1[7]} * inv; st_bf16x8(op + 32, a, b);
        a = (f32x4){o1[8], o1[9], o1[10], o1[11]} * inv; b = (f32x4){o1[12], o1[13], o1[14], o1[15]} * inv; st_bf16x8(op + 40, a, b);
    }
#undef ATT_FIRST
#undef ATT_FULL
#undef ATT_LAST
#undef ATT_IDLE
#undef ATT_MAXUPD
#undef ATT_QK_SUM
#undef ATT_LOAD
#undef ATT_STORE
}

#define XB_TMO      128
#define XB_XCNT(j)  (256  + 64 * (j))
#define XB_XSUB(j)  (1280 + 64 * (j))
#define XB_XGEN(j)  (2304 + 64 * (j))
#define XB_TOP      3328
#define XB_TOPGEN   3392
#define XCD_BAR_WORDS 3456
#define XB_SPIN_CAP (1u << 18)

__device__ __forceinline__ unsigned xb_ld(unsigned* p)              { return __hip_atomic_load(p, __ATOMIC_RELAXED, __HIP_MEMORY_SCOPE_AGENT); }
__device__ __forceinline__ unsigned xb_add(unsigned* p, unsigned v) { return __hip_atomic_fetch_add(p, v, __ATOMIC_RELAXED, __HIP_MEMORY_SCOPE_AGENT); }
__device__ __forceinline__ unsigned xb_xcc_id() { return (unsigned)__builtin_amdgcn_s_getreg((3 << 11) | 20) & 0xFu; }
#define XB_SPIN(cond, bar) do { unsigned _sp = 0; while (cond) { __builtin_amdgcn_s_sleep(1); \
    if ((++_sp & 255u) == 0u) { if (xb_ld(&(bar)[XB_TMO])) break; if (_sp > XB_SPIN_CAP) { atomicAdd(&(bar)[XB_TMO], 1u); break; } } } } while (0)

struct XcdBarrier {
    unsigned* bar; unsigned x;
    volatile LAS unsigned* st;
};

__device__ __forceinline__ XcdBarrier xcd_barrier_post(unsigned* bar, volatile LAS unsigned* st) {
    XcdBarrier b; b.bar = bar; b.x = xb_xcc_id(); b.st = st;
    if (threadIdx.x == 0) (void)xb_add(&bar[XB_XCNT(b.x)], 1u);
    return b;
}
__device__ __forceinline__ void xcd_barrier_complete(unsigned* bar, unsigned x, unsigned& nloc, unsigned& nx) {
    const unsigned G = gridDim.x * gridDim.y * gridDim.z;
    unsigned sum, cnt, mine, sp = 0u;
    for (;;) {
        sum = 0u; cnt = 0u; mine = 0u;
#pragma unroll
        for (unsigned j = 0; j < 16; ++j) { const unsigned c = xb_ld(&bar[XB_XCNT(j)]); sum += c; cnt += (c > 0u) ? 1u : 0u; mine = (j == x) ? c : mine; }
        if (sum == G) break;
        __builtin_amdgcn_s_sleep(1);
        if ((++sp & 255u) == 0u) { if (xb_ld(&bar[XB_TMO])) break; if (sp > XB_SPIN_CAP) { atomicAdd(&bar[XB_TMO], 1u); break; } }
    }
    nloc = mine > 0u ? mine : 1u; nx = cnt > 0u ? cnt : 1u;
}

__device__ __forceinline__ void xcd_barrier(const XcdBarrier& b) {
    asm volatile("s_waitcnt vmcnt(0)" ::: "memory");
    __syncthreads();
    if (threadIdx.x == 0) {
        unsigned* bar = b.bar;
        __builtin_amdgcn_s_waitcnt(0);
        unsigned nloc = b.st[0], nx = b.st[1];
        if (nloc == 0u) { xcd_barrier_complete(bar, b.x, nloc, nx); b.st[0] = nloc; b.st[1] = nx; }
        const unsigned old = xb_add(&bar[XB_XSUB(b.x)], 1u);
        const unsigned gen = old / nloc;
        if (old + 1u == (gen + 1u) * nloc) {
            __builtin_amdgcn_fence(__ATOMIC_RELEASE, "agent");
            asm volatile("s_waitcnt vmcnt(0)" ::: "memory");
            const unsigned og = xb_add(&bar[XB_TOP], 1u);
            const unsigned tg = og / nx;
            if (og + 1u == (tg + 1u) * nx) xb_add(&bar[XB_TOPGEN], 1u);
            else XB_SPIN(xb_ld(&bar[XB_TOPGEN]) == tg, bar);
            __builtin_amdgcn_fence(__ATOMIC_ACQUIRE, "agent");
            xb_add(&bar[XB_XGEN(b.x)], 1u);
            asm volatile("s_waitcnt vmcnt(0)" ::: "memory");
        } else {
            XB_SPIN(xb_ld(&bar[XB_XGEN(b.x)]) == gen, bar);
            __builtin_amdgcn_fence(__ATOMIC_ACQUIRE, "agent");
            asm volatile("s_waitcnt vmcnt(0)" ::: "memory");
        }
    }
    __syncthreads();
}

__global__ void __launch_bounds__(512, 2) fwd_kernel(Params prm) {
    extern __shared__ __attribute__((aligned(16))) unsigned char lds_raw[];
    cg::grid_group grid = cg::this_grid();
    LAS unsigned char* lds = (LAS unsigned char*)lds_raw;
#define FRESH_TID() int tid = threadIdx.x; asm volatile("" : "+v"(tid)); const int lane = tid & 63, wave = __builtin_amdgcn_readfirstlane(tid >> 6); \
    const int gw = vcu * 8 + wave, NGW = G * 8; const size_t gtid = (size_t)bid * 512 + tid, gsz = (size_t)G * 512; (void)lane; (void)gw; (void)NGW; (void)gtid; (void)gsz
    const int G = gridDim.x, bid = blockIdx.x;
    const int vcu = (G % 8 == 0) ? (bid % 8) * (G / 8) + bid / 8 : bid;
    Ctx C; C.p = prm;
    volatile LAS unsigned* bst = (volatile LAS unsigned*)(lds + 131072 + 64);
    if (threadIdx.x < 2) bst[threadIdx.x] = 0u;
    __syncthreads();
    const XcdBarrier xbar = xcd_barrier_post((unsigned*)(prm.ws + OFF_BAR), bst);
#define GRID_BAR() xcd_barrier(xbar)

#ifndef REP_PRO
#define REP_PRO 1
#endif
    for (int rep0 = 0; rep0 < REP_PRO; ++rep0) {
    { FRESH_TID();
    for (int it = bid; it < 96; it += G) gemv_item<0>(C, lds, prm.w_ada, 6144, it * 64, prm.b_ada, C.mod(), 6144, tid, wave, lane);
    {
        LAS float* scr = (LAS float*)lds + wave * (64 * 33);
        constexpr int I0 = 16 * 88, I1 = 12 * 24, I2 = 4 * 16, I3 = 4 * 16, I4 = 16 * 32, I5 = 16 * 176, I6 = 44 * 32;
        constexpr int NIT = I0 + I1 + I2 + I3 + I4 + I5 + I6;
        for (int it = gw; it < NIT; it += NGW) {
            int r = it, mat, K, nblk; bf16_t* WT;
            if (r < I0) { mat = 0; K = 1024; nblk = 88; WT = C.Win(); }
            else if ((r -= I0) < I1) { mat = 1; K = 768; nblk = 24; WT = C.Wuq(); }
            else if ((r -= I1) < I2) { mat = 2; K = 256; nblk = 16; WT = C.Wkn(); }
            else if ((r -= I2) < I3) { mat = 3; K = 256; nblk = 16; WT = C.Wv(); }
            else if ((r -= I3) < I4) { mat = 4; K = 1024; nblk = 32; WT = C.Wout(); }
            else if ((r -= I4) < I5) { mat = 5; K = 1024; nblk = 176; WT = C.Wgu(); }
            else { r -= I5; mat = 6; K = 2816; nblk = 32; WT = C.Wdn(); }
            transpose_item(C, mat, K, WT, scr, r, nblk, lane);
        }
        for (size_t idx0 = gtid; idx0 < (size_t)32 * PAST * 32; idx0 += 4 * gsz) {
            f32x4 a[4], c[4];
#pragma unroll
            for (int u = 0; u < 4; ++u) { const size_t idx = idx0 + u * gsz; if (idx < (size_t)32 * PAST * 32) { const float* s = prm.cache_lat + idx * 8; a[u] = *(const f32x4*)s; c[u] = *(const f32x4*)(s + 4); } }
#pragma unroll
            for (int u = 0; u < 4; ++u) { const size_t idx = idx0 + u * gsz; if (idx < (size_t)32 * PAST * 32) {
                const int bt = (int)(idx >> 5), c8 = (int)(idx & 31) * 8, bb = bt >> 11, t = bt & 2047;
                st_bf16x8(C.lat() + (size_t)(TP + bb * TKS + t) * 256 + c8, a[u], c[u]); } }
        }
        for (size_t idx = gtid; idx < (size_t)32 * PAST * 4; idx += gsz) {
            const int bt = (int)(idx >> 2), c8 = (int)(idx & 3) * 8, bb = bt >> 11, t = bt & 2047;
            const float* s = prm.cache_kr + (size_t)bt * 32 + c8;
            st_bf16x8(C.krb() + (size_t)(TP + bb * TKS + t) * 32 + c8, *(const f32x4*)s, *(const f32x4*)(s + 4));
        }
    }
    }
    if (prm.ws == nullptr) grid.sync();
    GRID_BAR();

    { FRESH_TID();
    for (int it = bid; it < 88; it += G) {
        const bool up = it >= 44;
        gemv_item<1>(C, lds, up ? prm.w_up : prm.w_gate, 2816, (up ? it - 44 : it) * 64, nullptr, up ? C.bu() : C.bg(), 2816, tid, wave, lane);
    }
    for (int row4 = gw * 4; row4 < TP; row4 += NGW * 4) h1_group<4>(C, row4, lane);
    for (int row = TP + gw; row < MT; row += NGW) h1_group<1>(C, row, lane);
    }
    GRID_BAR();
    }

#ifdef PROBE_SYNC
    for (int i = 0; i < PROBE_SYNC; ++i) GRID_BAR();
#endif
#pragma nounroll
    for (int job = 0; job < 8; ++job) {
        pg8::Gemm g; int rot = 0;
        if (job == 0) { g.A = C.h1(); g.Bt = C.Win(); g.M = MT; g.N = NIN; g.K = 1024; }
        else if (job == 1) { g.A = C.cq(); g.Bt = C.Wuq(); g.M = MT; g.N = 768; g.K = 768; }
        else if (job == 2) { g.A = C.lat(); g.Bt = C.Wkn(); g.M = LROWS; g.N = 512; g.K = 256; rot = 12; }
        else if (job == 3) { g.A = C.Wv(); g.Bt = C.lat(); g.M = 512; g.N = LROWS; g.K = 256; rot = 20; }
        else if (job == 4) { g.A = C.mix(); g.Bt = C.Wout(); g.M = MT; g.N = 1024; g.K = 1024; }
        else if (job == 5) { g.A = C.A2(); g.Bt = C.Wgu(); g.M = MT; g.N = NGU; g.K = 1024; }
        else if (job == 6) { g.A = C.hff(); g.Bt = C.Wdn(); g.M = TP; g.N = 1024; g.K = 2816; }
        else { g.A = C.hff() + (size_t)TP * DFF; g.Bt = C.Wdn(); g.M = TS; g.N = 1024; g.K = 256; rot = 40; }
        g.ld = g.K; if (job == 7) g.ld = DFF;
        pg8::StaticOrder S; S.init(g.M, g.N, G, (bid + G - rot % G) % G);
        if (job == 7) S.split = 11;
        if (job == 5 || job == 1 || job == 2) S.rev = 1;
        EpiAll E{C, job};
#ifndef REPMASK
#define REPMASK 0
#endif
        const int nrep = 1 + ((REPMASK >> job) & 1);
#pragma nounroll
        for (int rep = 0; rep < nrep; ++rep) {
#ifdef REP_NOEPI
        if (rep == 1) E.mode = 99;
#endif
        pg8::gemm_phase<EpiAll, pg8::StaticOrder, true, true>(lds, g, S, E);
        }
        if (job == 1 || job == 2 || job == 6) continue;
        if (job == 3) {
            { FRESH_TID();
            {
                const int c8 = (int)(gtid & 63) * 8;
                float w0[8], w1[8], w2[8], cb[8];
#pragma unroll
                for (int i = 0; i < 8; ++i) { w0[i] = prm.conv_w[c8 + i]; w1[i] = prm.conv_w[512 + c8 + i]; w2[i] = prm.conv_w[1024 + c8 + i]; cb[i] = prm.conv_b[c8 + i]; }
                for (int q = (int)(gtid >> 6); q < MT / 4; q += (int)(gsz >> 6)) {
                    const int row = q * 4, t0 = row < TP ? (row & 8191) : ((row - TP) & 31);
                    u32x4 gw_[6], gq_[4];
#pragma unroll
                    for (int r = 0; r < 4; ++r) { gw_[2 + r] = *(const u32x4*)(C.gi() + (size_t)(row + r) * 512 + c8); gq_[r] = *(const u32x4*)(C.gb() + (size_t)(row + r) * 512 + c8); }
                    float e[6][8];
                    if (t0 != 0) { gw_[0] = *(const u32x4*)(C.gi() + (size_t)(row - 2) * 512 + c8); gw_[1] = *(const u32x4*)(C.gi() + (size_t)(row - 1) * 512 + c8); }
                    else { gw_[0] = (u32x4){0, 0, 0, 0}; gw_[1] = (u32x4){0, 0, 0, 0}; }
#pragma unroll
                    for (int r = 0; r < 6; ++r)
#pragma unroll
                        for (int i = 0; i < 4; ++i) { e[r][2 * i] = __uint_as_float(gw_[r][i] << 16); e[r][2 * i + 1] = __uint_as_float(gw_[r][i] & 0xffff0000u); }
                    if (t0 == 0 && row >= TP) {
                        const float* sc = prm.state_conv + (size_t)((row - TP) >> 5) * 1024 + c8;
#pragma unroll
                        for (int i = 0; i < 8; ++i) { e[0][i] = sc[i]; e[1][i] = sc[512 + i]; }
                    }
#pragma unroll
                    for (int r = 0; r < 4; ++r) {
                        float y[8];
#pragma unroll
                        for (int i = 0; i < 4; ++i) {
                            const float g0 = __uint_as_float(gq_[r][i] << 16), g1 = __uint_as_float(gq_[r][i] & 0xffff0000u);
                            y[2 * i] = g0 * (w0[2 * i] * e[r][2 * i] + w1[2 * i] * e[r + 1][2 * i] + w2[2 * i] * e[r + 2][2 * i] + cb[2 * i]);
                            y[2 * i + 1] = g1 * (w0[2 * i + 1] * e[r][2 * i + 1] + w1[2 * i + 1] * e[r + 1][2 * i + 1] + w2[2 * i + 1] * e[r + 2][2 * i + 1] + cb[2 * i + 1]);
                        }
                        st_bf16x8(C.mix() + (size_t)(row + r) * DM + 512 + c8, (f32x4){y[0], y[1], y[2], y[3]}, (f32x4){y[4], y[5], y[6], y[7]});
                    }
                }
            }
            {
                for (int row8 = gw * 8; row8 < MT; row8 += NGW * 8) {
                    float* o = C.p.out + (row8 < TP ? OLP + (size_t)row8 * 256 : OLS + (size_t)(row8 - TP) * 256) + lane * 4;
                    const bf16_t* src = C.lat() + (size_t)latrow_of(row8) * 256 + lane * 4;
                    u32x2 w[8]; f32x4 sv[8];
#pragma unroll
                    for (int r = 0; r < 8; ++r) { w[r] = *(const u32x2*)(src + r * 256); sv[r] = *(const f32x4*)(C.ssq_kv() + (size_t)(row8 + r) * 4); }
#pragma unroll
                    for (int r = 0; r < 8; ++r) { const float rs = rsqrtf(sum4(sv[r]) * (1.0f / 256.0f) + EPS);
                        *(f32x4*)(o + r * 256) = (f32x4){__uint_as_float(w[r].x << 16), __uint_as_float(w[r].x & 0xffff0000u), __uint_as_float(w[r].y << 16), __uint_as_float(w[r].y & 0xffff0000u)} * rs; }
                }
            }
            }
            GRID_BAR();
            FRESH_TID();
#ifndef REP_ATTN
#define REP_ATTN 1
#endif
            for (int rep = 0; rep < REP_ATTN; ++rep)
            for (int it = vcu; it < 1024 + 256; it += G) {
                const int nsub = it < 1024 ? 2 : 1;
                for (int sub = 0; sub < nsub; ++sub) {
                    int kvbase, NT, wlim, qrow, h; bool half_last;
                    if (it < 1024) { const int bh = it >> 4, s = it & 15, qt = sub ? 31 - s : s, b = bh >> 3; h = bh & 7;
                        kvbase = b * 8192; NT = 4 * qt + 4; wlim = 4 * qt + (wave >> 1); half_last = false; qrow = b * 8192 + 256 * qt + 32 * wave + (lane & 31); }
                    else { const int su = it - 1024, b = su >> 3; h = su & 7;
                        kvbase = TP + b * TKS; NT = 33; wlim = wave == 0 ? 32 : -1; half_last = true; qrow = TP + b * 32 + (lane & 31); }
#if defined(PROBE_ATT) && PROBE_ATT == 2
                    if (rep == 1) wlim = -1;
#endif
#if defined(PROBE_ATT) && PROBE_ATT == 1
                    attn_unit(C, lds, kvbase, NT, wlim, half_last, qrow, h, tid, lane, rep == 1);
#else
                    attn_unit(C, lds, kvbase, NT, wlim, half_last, qrow, h, tid, lane, false);
#endif
                }
            }
        }
        GRID_BAR();
    }
    FRESH_TID();
    for (int row4 = gw * 4; row4 < MT; row4 += NGW * 4) {
        const bf16_t* xr = C.xb() + (size_t)row4 * DM + 8 * lane;
        f32x4 v[4][4];
#pragma unroll
        for (int r = 0; r < 4; ++r) { ld_bf16x8(xr + (size_t)r * DM, v[r][0], v[r][1]); ld_bf16x8(xr + (size_t)r * DM + 512, v[r][2], v[r][3]); }
        if (row4 >= TP) {
            const float* mb = C.mod() + (size_t)(8 + ((row4 - TP) >> 5)) * 6144 + 5120 + 8 * lane;
            f32x4 a[4][4];
#pragma unroll
            for (int r = 0; r < 4; ++r)
#pragma unroll
                for (int j = 0; j < 4; ++j) a[r][j] = (f32x4){0.f, 0.f, 0.f, 0.f};
            for (int kc = 0; kc < 11; ++kc) {
                const float* pp = C.part() + ((size_t)kc * 1024 + (row4 - TP)) * 1024 + 8 * lane;
#pragma unroll
                for (int r = 0; r < 4; ++r)
#pragma unroll
                    for (int j = 0; j < 4; ++j) a[r][j] += *(const f32x4*)(pp + (size_t)r * 1024 + (j >> 1) * 512 + (j & 1) * 4);
            }
#pragma unroll
            for (int j = 0; j < 4; ++j) { const f32x4 g2 = *(const f32x4*)(mb + (j >> 1) * 512 + (j & 1) * 4);
#pragma unroll
                for (int r = 0; r < 4; ++r) v[r][j] += g2 * a[r][j]; }
        }
        float rs[4];
#pragma unroll
        for (int r = 0; r < 4; ++r) rs[r] = dot4(v[r][0]) + dot4(v[r][1]) + dot4(v[r][2]) + dot4(v[r][3]);
#pragma unroll
        for (int of = 1; of < 64; of <<= 1) {
#pragma unroll
            for (int r = 0; r < 4; ++r) rs[r] += __shfl_xor(rs[r], of);
        }
#pragma unroll
        for (int r = 0; r < 4; ++r) rs[r] = rsqrtf(rs[r] * (1.0f / 1024.0f) + EPS);
        float* o = C.p.out + OY + (size_t)row4 * DM + 8 * lane;
#pragma unroll
        for (int j = 0; j < 4; ++j) {
            const int co = (j >> 1) * 512 + (j & 1) * 4;
            const f32x4 g = *(const f32x4*)(prm.final_g + 8 * lane + co);
#pragma unroll
            for (int r = 0; r < 4; ++r) *(f32x4*)(o + (size_t)r * DM + co) = v[r][j] * rs[r] * g;
        }
    }
}

extern "C" void kernel_launch(void* const* d_in, const int* in_sizes, int n_in, void* d_out, int out_size, void* d_ws, size_t ws_size, hipStream_t stream) {
    static int grid = 0;
    if (grid == 0) {
        int dev = 0, cus = 0, per_cu = 0;
        if (n_in != 23 || ws_size < WS_NEED) { fprintf(stderr, "kernel_launch: unexpected inputs (n_in %d, ws %zu)\n", n_in, ws_size); grid = -1; return; }
        hipGetDevice(&dev);
        hipDeviceGetAttribute(&cus, hipDeviceAttributeMultiprocessorCount, dev);
        hipFuncSetAttribute((const void*)fwd_kernel, hipFuncAttributeMaxDynamicSharedMemorySize, LDS_BYTES);
        hipOccupancyMaxActiveBlocksPerMultiprocessor(&per_cu, (const void*)fwd_kernel, 512, LDS_BYTES);
        if (per_cu < 1) per_cu = 1;
        grid = cus * per_cu;
        (void)hipGetLastError();
    }
    if (grid < 0) return;
    if (hipMemsetAsync((char*)d_ws + OFF_BAR, 0, 3456 * 4, stream) != hipSuccess) { fprintf(stderr, "kernel_launch: memset of the barrier words failed\n"); return; }
    Params p{};
    const float** f = (const float**)&p;
    for (int i = 0; i < 23; ++i) f[i] = (const float*)d_in[i];
    p.out = (float*)d_out; p.ws = (unsigned char*)d_ws;
    void* args[] = {&p};
    hipError_t e = hipLaunchCooperativeKernel((const void*)fwd_kernel, dim3(grid), dim3(512), args, LDS_BYTES, stream);
    if (e != hipSuccess) fprintf(stderr, "cooperative launch failed: %s (grid %d)\n", hipGetErrorString(e), grid);
}
```

```cpp
#include <hip/hip_runtime.h>
#include <hip/hip_cooperative_groups.h>
#include <cstdio>
#include <cstdint>
#include <cmath>
namespace cg = cooperative_groups;
namespace pg8 {
#define PG8_LAS __attribute__((address_space(3)))
typedef unsigned short bf16_t;
typedef short bf16x8 __attribute__((ext_vector_type(8)));
typedef float f32x4 __attribute__((ext_vector_type(4)));
typedef unsigned u32x4 __attribute__((ext_vector_type(4)));
constexpr int BM = 256, BK = 64, HALF = 128, HTB = HALF * BK * 2  , STAGE_BYTES = 8 * HTB, NXCD = 8, WGM = 8;

__host__ __device__ __forceinline__ int lds_byte(int r, int c) { const int st = (r >> 4) * 2 + (c >> 5), rr = r & 15, cc = c & 31, ob = rr * 64 + cc * 2; return st * 1024 + (ob ^ (((ob >> 9) & 1) << 5)); }
__host__ __device__ __forceinline__ void stage_rc(int b, int& R, int& C) { const int st = b / 1024, sb = b % 1024, swz = sb ^ (((sb >> 9) & 1) << 5); R = (st >> 1) * 16 + swz / 64; C = (st & 1) * 32 + (swz % 64) / 2; }
__host__ __device__ __forceinline__ int perm32(int rho) { const int n = rho >> 4, i = rho & 15; return 8 * (i >> 2) + 4 * n + (i & 3); }

struct Unit { int pm, pn, kc; };
struct Gemm { const bf16_t* A; const bf16_t* Bt; int M, N, K, ld; };

struct StaticOrder {
    int nM, nN, nwg, G, c, split, rev;
    __host__ __device__ void init(int M, int N, int G_, int c_) { nM = M / BM; nN = N / BM; nwg = nM * nN; G = G_; c = c_; split = 0; rev = 0; }
    __host__ __device__ bool next(int i, Unit& u) const {
        u.kc = 0;
        if (split) { if (i != 0 || c >= split * nwg) return false; u.kc = c / nwg; const int r = c % nwg; u.pm = r / nN; u.pn = r % nN; return true; }
        const long L = (long)i * G + c; if (L >= nwg) return false;
        int wgid = (int)L; { const int q = nwg / NXCD, r = nwg % NXCD, xcd = wgid % NXCD, off = wgid / NXCD; wgid = (xcd < r ? xcd * (q + 1) : r * (q + 1) + (xcd - r) * q) + off; }
        const int nig = WGM * nN, gid = wgid / nig, fm = gid * WGM, gsz = (nM - fm) < WGM ? (nM - fm) : WGM;
        u.pm = fm + ((wgid % nig) % gsz); u.pn = (wgid % nig) / gsz; if (rev) u.pm = nM - 1 - u.pm; return true;
    }
    __device__ __forceinline__ void a_ready(const Unit&) const {}
    __device__ __forceinline__ void done(const Unit&) const {}
};
__device__ __forceinline__ unsigned cvt_pk_bf16(float lo, float hi) { unsigned r; asm volatile("v_cvt_pk_bf16_f32 %0, %1, %2" : "=v"(r) : "v"(lo), "v"(hi)); return r; }
template <class Epi, class Sched, bool ALIGN_EPI = false, bool SP2 = false>
__device__ __forceinline__ void gemm_phase(PG8_LAS unsigned char* lds, const Gemm g, const Sched& S, const Epi& E) {
    int tid_ = threadIdx.x; asm volatile("" : "+v"(tid_));
    const int tid = tid_, wid = __builtin_amdgcn_readfirstlane(tid >> 6), lane = tid & 63, wr = wid >> 2, wc = wid & 3, fr = lane & 15, fq = lane >> 4;
    const int K = g.K, nt = K / BK;
    unsigned voffA[2], voffB[2];
#pragma unroll
    for (int i = 0; i < 2; ++i) { int R, C; stage_rc(tid * 16 + i * 8192, R, C); const int Rb = Epi::PERM ? ((R & ~31) + perm32(R & 31)) : R;
        voffA[i] = (unsigned)(R * g.ld + C) * 2u; voffB[i] = (unsigned)(Rb * g.ld + C) * 2u; }
    const size_t kstep = (size_t)(BK * 2);
    const size_t hstep = (size_t)HALF * g.ld * 2;
    const size_t tstep = 2 * hstep;
    const unsigned ldsw = (unsigned)wid * 1024u;
    const int aoff = lds_byte(wr * 64 + fr, fq * 8), boff = lds_byte(wc * 32 + fr, fq * 8);
#define PG8_SA(b, h) (((b) * 2 + (h)) * HTB)
#define PG8_SB(b, h) ((4 + (b) * 2 + (h)) * HTB)
#define PG8_STAGE(bufoff, gbase, voff) do { _Pragma("unroll") for (int _i = 0; _i < 2; ++_i) \
        __builtin_amdgcn_global_load_lds((const unsigned*)((const char*)(gbase) + (voff)[_i]), (PG8_LAS unsigned*)(lds + (bufoff) + ldsw + _i * 8192), 16, 0, 0); } while (0)
#define PG8_LDA(dst, b, h) do { _Pragma("unroll") for (int m = 0; m < 4; ++m) _Pragma("unroll") for (int k = 0; k < 2; ++k) dst[m][k] = *(const PG8_LAS bf16x8*)(lds + PG8_SA(b, h) + aoff + m * 2048 + k * 1024); } while (0)
#define PG8_LDB(dst, b, h) do { _Pragma("unroll") for (int n = 0; n < 2; ++n) _Pragma("unroll") for (int k = 0; k < 2; ++k) dst[n][k] = *(const PG8_LAS bf16x8*)(lds + PG8_SB(b, h) + boff + n * 2048 + k * 1024); } while (0)
#define PG8_MMA(ai, bj, At, Bt) do { __builtin_amdgcn_s_setprio(1); _Pragma("unroll") for (int m = 0; m < 4; ++m) _Pragma("unroll") for (int n = 0; n < 2; ++n) _Pragma("unroll") for (int k = 0; k < 2; ++k) \
        acc[ai][bj][m][n] = __builtin_amdgcn_mfma_f32_16x16x32_bf16(Bt[n][k], At[m][k], acc[ai][bj][m][n], 0, 0, 0); __builtin_amdgcn_s_setprio(0); } while (0)
#define PG8_WAIT_V(n) asm volatile("s_waitcnt vmcnt(" #n ")" ::: "memory")
#define PG8_WAIT_L(n) asm volatile("s_waitcnt lgkmcnt(" #n ")" ::: "memory")
#define PG8_BAR __builtin_amdgcn_s_barrier()
#define PG8_SCHED __builtin_amdgcn_sched_barrier(0)
    Unit cur, nxt; int ui = 0;
    if (!S.next(0, cur)) return;
    f32x4 acc[2][2][4][2];
#pragma unroll
    for (int a = 0; a < 2; ++a)
#pragma unroll
        for (int b = 0; b < 2; ++b)
#pragma unroll
            for (int m = 0; m < 4; ++m)
#pragma unroll
                for (int n = 0; n < 2; ++n) acc[a][b][m][n] = (f32x4){0.f, 0.f, 0.f, 0.f};
    bf16x8 At[4][2], B0[2][2], B1[2][2];
    const char* cA = (const char*)g.A + (size_t)cur.pm * tstep + (size_t)cur.kc * K * 2; const char* cB = (const char*)g.Bt + (size_t)cur.pn * tstep + (size_t)cur.kc * K * 2;
    S.a_ready(cur);
    if constexpr (SP2) {
        PG8_STAGE(PG8_SB(0, 0), cB, voffB); PG8_STAGE(PG8_SB(0, 1), cB + hstep, voffB); PG8_STAGE(PG8_SA(0, 0), cA, voffA); PG8_STAGE(PG8_SA(0, 1), cA + hstep, voffA);
        if (wr == 1) PG8_BAR;
        PG8_WAIT_V(2); PG8_BAR;
        PG8_STAGE(PG8_SB(1, 0), cB + kstep, voffB); PG8_STAGE(PG8_SA(1, 0), cA + kstep, voffA); PG8_STAGE(PG8_SB(1, 1), cB + hstep + kstep, voffB);
        PG8_WAIT_V(6); PG8_BAR;
    } else {
        PG8_STAGE(PG8_SB(0, 0), cB, voffB); PG8_STAGE(PG8_SA(0, 0), cA, voffA); PG8_STAGE(PG8_SB(0, 1), cB + hstep, voffB); PG8_STAGE(PG8_SA(0, 1), cA + hstep, voffA);
        if (wr == 1) PG8_BAR;
        PG8_WAIT_V(4); PG8_BAR;
        PG8_STAGE(PG8_SB(1, 0), cB + kstep, voffB); PG8_STAGE(PG8_SA(1, 0), cA + kstep, voffA); PG8_STAGE(PG8_SB(1, 1), cB + hstep + kstep, voffB);
        PG8_WAIT_V(6); PG8_BAR;
    }
    for (;;) {
        const bool has_next = S.next(ui + 1, nxt);
        const char* nA = has_next ? (const char*)g.A + (size_t)nxt.pm * tstep + (size_t)nxt.kc * K * 2 : cA; const char* nB = has_next ? (const char*)g.Bt + (size_t)nxt.pn * tstep + (size_t)nxt.kc * K * 2 : cB;
        for (int t = 0; t < nt; t += 2) {
            const bool last = (t == nt - 2);
            const char* a1 = cA + (size_t)(t + 1) * kstep;
            const char* a2 = last ? nA : cA + (size_t)(t + 2) * kstep; const char* b2 = last ? nB : cB + (size_t)(t + 2) * kstep;
            const char* a3 = a2 + kstep; const char* b3 = b2 + kstep;
            if (last && has_next) S.a_ready(nxt);
            if constexpr (SP2) {
            PG8_LDB(B0, 0, 0); PG8_LDB(B1, 0, 1); PG8_SCHED; PG8_LDA(At, 0, 0); PG8_STAGE(PG8_SA(1, 1), a1 + hstep, voffA);
            PG8_WAIT_V(8); PG8_WAIT_L(0); PG8_BAR; PG8_MMA(0, 0, At, B0); PG8_MMA(0, 1, At, B1); PG8_BAR; PG8_SCHED;
            PG8_LDA(At, 0, 1); PG8_STAGE(PG8_SB(0, 0), b2, voffB); PG8_STAGE(PG8_SB(0, 1), b2 + hstep, voffB); PG8_STAGE(PG8_SA(0, 0), a2, voffA);
            PG8_WAIT_V(8); PG8_WAIT_L(0); PG8_BAR; PG8_MMA(1, 0, At, B0); PG8_MMA(1, 1, At, B1); PG8_BAR; PG8_SCHED;
            PG8_LDB(B0, 1, 0); PG8_LDB(B1, 1, 1); PG8_SCHED; PG8_LDA(At, 1, 0); PG8_STAGE(PG8_SA(0, 1), a2 + hstep, voffA);
            PG8_WAIT_V(8); PG8_WAIT_L(0); PG8_BAR; PG8_MMA(0, 0, At, B0); PG8_MMA(0, 1, At, B1); PG8_BAR; PG8_SCHED;
            PG8_LDA(At, 1, 1); PG8_STAGE(PG8_SB(1, 0), b3, voffB); PG8_STAGE(PG8_SB(1, 1), b3 + hstep, voffB); PG8_STAGE(PG8_SA(1, 0), a3, voffA);
            PG8_WAIT_V(8); PG8_WAIT_L(0); PG8_BAR; PG8_MMA(1, 0, At, B0); PG8_MMA(1, 1, At, B1); PG8_BAR; PG8_SCHED;
            } else {
            PG8_LDB(B0, 0, 0); PG8_SCHED; PG8_LDA(At, 0, 0); PG8_STAGE(PG8_SA(1, 1), a1 + hstep, voffA);
            PG8_WAIT_L(8); PG8_BAR; PG8_WAIT_L(0); PG8_MMA(0, 0, At, B0); PG8_BAR; PG8_SCHED;
            PG8_LDB(B1, 0, 1); PG8_STAGE(PG8_SB(0, 0), b2, voffB);
            PG8_BAR; PG8_WAIT_L(0); PG8_MMA(0, 1, At, B1); PG8_BAR;
            PG8_LDA(At, 0, 1); PG8_STAGE(PG8_SA(0, 0), a2, voffA);
            PG8_BAR; PG8_WAIT_L(0); PG8_MMA(1, 0, At, B0); PG8_BAR; PG8_SCHED;
            PG8_STAGE(PG8_SB(0, 1), b2 + hstep, voffB);
            PG8_WAIT_V(6); PG8_BAR; PG8_MMA(1, 1, At, B1); PG8_BAR;
            PG8_LDB(B0, 1, 0); PG8_SCHED; PG8_LDA(At, 1, 0); PG8_STAGE(PG8_SA(0, 1), a2 + hstep, voffA);
            PG8_WAIT_L(8); PG8_BAR; PG8_WAIT_L(0); PG8_MMA(0, 0, At, B0); PG8_BAR; PG8_SCHED;
            PG8_LDB(B1, 1, 1); PG8_STAGE(PG8_SB(1, 0), b3, voffB);
            PG8_BAR; PG8_WAIT_L(0); PG8_MMA(0, 1, At, B1); PG8_BAR;
            PG8_LDA(At, 1, 1); PG8_STAGE(PG8_SA(1, 0), a3, voffA);
            PG8_BAR; PG8_WAIT_L(0); PG8_MMA(1, 0, At, B0); PG8_BAR; PG8_SCHED;
            PG8_STAGE(PG8_SB(1, 1), b3 + hstep, voffB);
            PG8_WAIT_V(6); PG8_BAR; PG8_MMA(1, 1, At, B1); PG8_BAR;
            }
        }
        if constexpr (ALIGN_EPI) { if (wr == 0) PG8_BAR; }
        if constexpr (!Epi::AFTER_DRAIN) { E(acc, cur, wr, wc, fr, fq); S.done(cur); }
        if (!has_next) break;
#pragma unroll
        for (int a = 0; a < 2; ++a)
#pragma unroll
            for (int b = 0; b < 2; ++b)
#pragma unroll
                for (int m = 0; m < 4; ++m)
#pragma unroll
                    for (int n = 0; n < 2; ++n) acc[a][b][m][n] = (f32x4){0.f, 0.f, 0.f, 0.f};
        cur = nxt; cA = nA; cB = nB; ++ui;
        if constexpr (ALIGN_EPI) { if (wr == 1) PG8_BAR; }
    }
    PG8_WAIT_V(0);
    if constexpr (!ALIGN_EPI) { if (wr == 0) PG8_BAR; }
    PG8_BAR;
    if constexpr (Epi::AFTER_DRAIN) { E.fused(acc, cur, wr, wc, fr, fq, lds, wid, lane); S.done(cur); }
#undef PG8_SA
#undef PG8_SB
#undef PG8_STAGE
#undef PG8_LDA
#undef PG8_LDB
#undef PG8_MMA
#undef PG8_WAIT_V
#undef PG8_WAIT_L
#undef PG8_BAR
#undef PG8_SCHED
}
}

#define LAS __attribute__((address_space(3)))
typedef unsigned short bf16_t;
typedef short bf16x8 __attribute__((ext_vector_type(8)));
typedef float f32x4 __attribute__((ext_vector_type(4)));
typedef float f32x16 __attribute__((ext_vector_type(16)));
typedef unsigned u32x4 __attribute__((ext_vector_type(4)));
typedef unsigned u32x2 __attribute__((ext_vector_type(2)));

constexpr int DM = 1024, TP = 65536, TS = 1024, MT = TP + TS;
constexpr int PAST = 2048, TKS = 2080;
constexpr int LROWS = TP + 32 * TKS;
constexpr int LV = LROWS + 256;
constexpr int NIN = 2816, DFF = 2816, NGU = 5632;
constexpr float EPS = 1e-6f;
constexpr float QSCALE = 0.14724444602590306f;

constexpr unsigned OY = 0, OLP = 68157440, OKP = 84934656, OCP = 87031808, OLS = 87040000, OKS = 87302144, OCS = 87334912;

constexpr size_t MiB = 1u << 20;
constexpr size_t OFF_MOD = 0, OFF_BG = 1 * MiB, OFF_BU = 1 * MiB + 512 * 1024, OFF_SSQQ = 2 * MiB, OFF_SSQKV = 6 * MiB + 512 * 1024, OFF_SSQ1 = 8 * MiB, OFF_SSQ2 = 13 * MiB;
constexpr size_t OFF_WIN = 18 * MiB, OFF_WUQ = 24 * MiB, OFF_WKN = 26 * MiB, OFF_WV = 27 * MiB, OFF_WOUT = 28 * MiB, OFF_WGU = 30 * MiB, OFF_WDN = 41 * MiB;
constexpr size_t OFF_CQ = 48 * MiB, OFF_LAT = 146 * MiB, OFF_GI = 211 * MiB, OFF_GB = 276 * MiB, OFF_KRB = 341 * MiB, OFF_A2 = 48 * MiB;
constexpr size_t OFF_QN = 350 * MiB, OFF_QR = 415 * MiB, OFF_KN = 448 * MiB, OFF_VT = 577 * MiB, OFF_MIX = 707 * MiB, OFF_H1 = 448 * MiB, OFF_HFF = 350 * MiB;
constexpr size_t OFF_BAR = 1000 * 1024;
constexpr size_t WS_NEED = 838 * MiB;

constexpr int LDS_BYTES = 147456;

struct Params {
    const float *x_p, *x_s, *c_p, *c_s, *cache_lat, *cache_kr, *state_conv;
    const float *w_ada, *b_ada, *norm_mix_g, *w_in, *q_norm_g, *w_uq, *kv_norm_g, *w_ukv, *conv_w, *conv_b, *w_out, *norm_ffn_g, *w_gate, *w_up, *w_down, *final_g;
    float* out; unsigned char* ws;
};

struct Ctx {
    Params p;
    __device__ __forceinline__ float* mod() const { return (float*)(p.ws + OFF_MOD); }
    __device__ __forceinline__ float* bg() const { return (float*)(p.ws + OFF_BG); }
    __device__ __forceinline__ float* bu() const { return (float*)(p.ws + OFF_BU); }
    __device__ __forceinline__ float* ssq_q() const { return (float*)(p.ws + OFF_SSQQ); }
    __device__ __forceinline__ float* ssq_kv() const { return (float*)(p.ws + OFF_SSQKV); }
    __device__ __forceinline__ float* ssq_x1() const { return (float*)(p.ws + OFF_SSQ1); }
    __device__ __forceinline__ float* ssq_x2() const { return (float*)(p.ws + OFF_SSQ2); }
    __device__ __forceinline__ bf16_t* Win() const { return (bf16_t*)(p.ws + OFF_WIN); }
    __device__ __forceinline__ bf16_t* Wuq() const { return (bf16_t*)(p.ws + OFF_WUQ); }
    __device__ __forceinline__ bf16_t* Wkn() const { return (bf16_t*)(p.ws + OFF_WKN); }
    __device__ __forceinline__ bf16_t* Wv() const { return (bf16_t*)(p.ws + OFF_WV); }
    __device__ __forceinline__ bf16_t* Wout() const { return (bf16_t*)(p.ws + OFF_WOUT); }
    __device__ __forceinline__ bf16_t* Wgu() const { return (bf16_t*)(p.ws + OFF_WGU); }
    __device__ __forceinline__ bf16_t* Wdn() const { return (bf16_t*)(p.ws + OFF_WDN); }
    __device__ __forceinline__ bf16_t* cq() const { return (bf16_t*)(p.ws + OFF_CQ); }
    __device__ __forceinline__ bf16_t* lat() const { return (bf16_t*)(p.ws + OFF_LAT); }
    __device__ __forceinline__ bf16_t* gi() const { return (bf16_t*)(p.ws + OFF_GI); }
    __device__ __forceinline__ bf16_t* gb() const { return (bf16_t*)(p.ws + OFF_GB); }
    __device__ __forceinline__ bf16_t* krb() const { return (bf16_t*)(p.ws + OFF_KRB); }
    __device__ __forceinline__ bf16_t* A2() const { return (bf16_t*)(p.ws + OFF_A2); }
    __device__ __forceinline__ float* part() const { return (float*)(p.ws + OFF_A2); }
    __device__ __forceinline__ bf16_t* xb() const { return (bf16_t*)(p.ws + OFF_GI); }
    __device__ __forceinline__ bf16_t* Qn() const { return (bf16_t*)(p.ws + OFF_QN); }
    __device__ __forceinline__ bf16_t* Qr() const { return (bf16_t*)(p.ws + OFF_QR); }
    __device__ __forceinline__ bf16_t* Kn() const { return (bf16_t*)(p.ws + OFF_KN); }
    __device__ __forceinline__ bf16_t* Vt() const { return (bf16_t*)(p.ws + OFF_VT); }
    __device__ __forceinline__ bf16_t* mix() const { return (bf16_t*)(p.ws + OFF_MIX); }
    __device__ __forceinline__ bf16_t* h1() const { return (bf16_t*)(p.ws + OFF_H1); }
    __device__ __forceinline__ bf16_t* hff() const { return (bf16_t*)(p.ws + OFF_HFF); }
};

__device__ const double ROPE_R[16] = {
    0.15915494309189535, 0.089499401608891013, 0.050329212104487035, 0.028302195830623399, 0.015915494309189534, 0.0089499401608891024, 0.0050329212104487037, 0.0028302195830623399,
    0.0015915494309189536, 0.00089499401608891024, 0.00050329212104487033, 0.00028302195830623395, 0.00015915494309189535, 8.9499401608891018e-05, 5.0329212104487035e-05, 2.8302195830623396e-05};

__device__ __forceinline__ unsigned pk2(float lo, float hi) { return pg8::cvt_pk_bf16(lo, hi); }
__device__ __forceinline__ void st_bf16x8(bf16_t* p, f32x4 a, f32x4 b) { u32x4 w; w.x = pk2(a[0], a[1]); w.y = pk2(a[2], a[3]); w.z = pk2(b[0], b[1]); w.w = pk2(b[2], b[3]); *(u32x4*)p = w; }
__device__ __forceinline__ void ld_bf16x8(const bf16_t* p, f32x4& a, f32x4& b) { const u32x4 w = *(const u32x4*)p;
    a = (f32x4){__uint_as_float(w.x << 16), __uint_as_float(w.x & 0xffff0000u), __uint_as_float(w.y << 16), __uint_as_float(w.y & 0xffff0000u)};
    b = (f32x4){__uint_as_float(w.z << 16), __uint_as_float(w.z & 0xffff0000u), __uint_as_float(w.w << 16), __uint_as_float(w.w & 0xffff0000u)}; }
__device__ __forceinline__ float dot4(f32x4 a) { return (a[0] * a[0] + a[1] * a[1]) + (a[2] * a[2] + a[3] * a[3]); }
__device__ __forceinline__ float sum4(f32x4 a) { return (a[0] + a[1]) + (a[2] + a[3]); }
__device__ __forceinline__ int batch_of(int row) { return row < TP ? (row >> 13) : 8 + ((row - TP) >> 5); }
__device__ __forceinline__ int pos_of(int row) { return row < TP ? (row & 8191) : PAST + ((row - TP) & 31); }
__device__ __forceinline__ int latrow_of(int row) { return row < TP ? row : TP + ((row - TP) >> 5) * TKS + PAST + ((row - TP) & 31); }
__device__ __forceinline__ void rope_cs(int pos, int i, float& c, float& s) {
    double t = (double)pos * ROPE_R[i]; t -= floor(t); const float tf = (float)t;
    c = __builtin_amdgcn_cosf(tf); s = __builtin_amdgcn_sinf(tf);
}
__device__ __forceinline__ float silu_f(float x) { return x * __builtin_amdgcn_rcpf(1.0f + __builtin_amdgcn_exp2f(-1.4426950408889634f * x)); }
__device__ __forceinline__ float rs_of_latrow(const Ctx& C, int L) {
    int tok;
    if (L < TP) tok = L;
    else { const int s = L - TP, b = s / TKS, t = s - b * TKS; if (t < PAST) return 1.0f; tok = TP + b * 32 + (t - PAST); }
    const f32x4 v = *(const f32x4*)(C.ssq_kv() + (unsigned)tok * 4);
    return rsqrtf(sum4(v) * (1.0f / 256.0f) + EPS);
}


__device__ __forceinline__ void row_stats8(const float* part, int row0, int fq, float inv_n, float (&rs)[8]) {
    f32x4 sp[8];
#pragma unroll
    for (int i = 0; i < 8; ++i) sp[i] = *(const f32x4*)(part + (unsigned)(row0 + (i >> 2) * 128 + (i & 3) * 16) * 16 + fq * 4);
#pragma unroll
    for (int i = 0; i < 8; ++i) { float s = sum4(sp[i]); s += __shfl_xor(s, 16); s += __shfl_xor(s, 32); rs[i] = rsqrtf(s * inv_n + EPS); }
}

struct EpiAll {
    static constexpr bool PERM = true, AFTER_DRAIN = false;
    const Ctx& C; int mode;
    __device__ __forceinline__ void operator()(const f32x4 (&acc)[2][2][4][2], const pg8::Unit& u, int wr_, int wc_, int fr_, int fq_) const {
        int wr = wr_, wc = wc_, fr = fr_, fq = fq_;
        asm volatile("" : "+s"(wr), "+s"(wc), "+v"(fr), "+v"(fq));
        const int row0 = u.pm * 256 + wr * 64 + fr, colw = wc * 32 + fq * 8, pn = u.pn;
        if (mode == 0) {
            if (pn < 4) {
                const bool isq = pn < 3;
                const float* gsrc = isq ? C.p.q_norm_g + pn * 256 : C.p.kv_norm_g;
                f32x4 g[2][2];
#pragma unroll
                for (int bj = 0; bj < 2; ++bj)
#pragma unroll
                    for (int n = 0; n < 2; ++n) g[bj][n] = *(const f32x4*)(gsrc + bj * 128 + colw + n * 4);
#pragma unroll
                for (int ai = 0; ai < 2; ++ai)
#pragma unroll
                    for (int m = 0; m < 4; ++m) {
                        const int row = row0 + ai * 128 + m * 16; float s = 0.f;
#pragma unroll
                        for (int bj = 0; bj < 2; ++bj) {
                            const f32x4 v0 = acc[ai][bj][m][0], v1 = acc[ai][bj][m][1]; s += dot4(v0) + dot4(v1);
                            bf16_t* dst;
                            if (isq) dst = C.cq() + (unsigned)row * 768 + pn * 256 + bj * 128 + colw;
                            else {
                                dst = C.lat() + (unsigned)latrow_of(row) * 256 + bj * 128 + colw;
                            }
                            st_bf16x8(dst, v0 * g[bj][0], v1 * g[bj][1]);
                        }
                        s += __shfl_xor(s, 16); s += __shfl_xor(s, 32);
                        if (fq == 0) { if (isq) { C.ssq_q()[(unsigned)row * 16 + pn * 4 + wc] = s; if (pn == 0) C.ssq_q()[(unsigned)row * 16 + 12 + wc] = 0.f; } else C.ssq_kv()[(unsigned)row * 4 + wc] = s; }
                    }
            } else if (pn < 8) {
                const int col = (pn - 4) * 128 + colw;
#pragma unroll
                for (int ai = 0; ai < 2; ++ai)
#pragma unroll
                    for (int m = 0; m < 4; ++m) {
                        const int row = row0 + ai * 128 + m * 16;
                        const f32x4 g0 = acc[ai][0][m][0] * acc[ai][1][m][0], g1 = acc[ai][0][m][1] * acc[ai][1][m][1];
                        st_bf16x8(C.gi() + (unsigned)row * 512 + col, g0, g1);
                        if (row < TP) { const int tt = row & 8191; if (tt >= 8190) { float* o = C.p.out + OCP + (unsigned)((row >> 13) * 2 + (tt - 8190)) * 512 + col; *(f32x4*)o = g0; *(f32x4*)(o + 4) = g1; } }
                        else { const int s = row - TP, tt = s & 31; if (tt >= 30) { float* o = C.p.out + OCS + (unsigned)((s >> 5) * 2 + (tt - 30)) * 512 + col; *(f32x4*)o = g0; *(f32x4*)(o + 4) = g1; } }
                    }
            } else if (pn < 10) {
#pragma unroll
                for (int ai = 0; ai < 2; ++ai)
#pragma unroll
                    for (int m = 0; m < 4; ++m) {
                        const int row = row0 + ai * 128 + m * 16;
#pragma unroll
                        for (int bj = 0; bj < 2; ++bj) st_bf16x8(C.gb() + (unsigned)row * 512 + (pn - 8) * 256 + bj * 128 + colw, acc[ai][bj][m][0], acc[ai][bj][m][1]);
                    }
            } else {
                if (wc == 0 && fq < 2) {
#pragma unroll
                    for (int ai = 0; ai < 2; ++ai)
#pragma unroll
                        for (int m = 0; m < 4; ++m) {
                            const int row = row0 + ai * 128 + m * 16, pos = pos_of(row);
                            f32x4 y1[2], y2[2];
#pragma unroll
                            for (int n = 0; n < 2; ++n)
#pragma unroll
                                for (int e = 0; e < 4; ++e) {
                                    float c, s; rope_cs(pos, fq * 8 + n * 4 + e, c, s);
                                    const float x1 = acc[ai][0][m][n][e], x2 = acc[ai][1][m][n][e];
                                    y1[n][e] = x1 * c - x2 * s; y2[n][e] = x1 * s + x2 * c;
                                }
                            float* o = C.p.out + (row < TP ? OKP + (unsigned)row * 32 : OKS + (unsigned)(row - TP) * 32) + fq * 8;
                            *(f32x4*)o = y1[0]; *(f32x4*)(o + 4) = y1[1]; *(f32x4*)(o + 16) = y2[0]; *(f32x4*)(o + 20) = y2[1];
                            bf16_t* kb = C.krb() + (unsigned)latrow_of(row) * 32 + fq * 8;
                            st_bf16x8(kb, y1[0], y1[1]); st_bf16x8(kb + 16, y2[0], y2[1]);
                        }
                }
            }
        } else if (mode == 1) {
            float rqv[8]; row_stats8(C.ssq_q(), row0, fq, 1.0f / 768.0f, rqv);
#pragma unroll
            for (int ai = 0; ai < 2; ++ai)
#pragma unroll
                for (int m = 0; m < 4; ++m) {
                    const int row = row0 + ai * 128 + m * 16;
                    const float rq = rqv[ai * 4 + m] * QSCALE;
                    if (pn < 2) {
#pragma unroll
                        for (int bj = 0; bj < 2; ++bj) st_bf16x8(C.Qn() + (unsigned)row * 512 + pn * 256 + bj * 128 + colw, acc[ai][bj][m][0] * rq, acc[ai][bj][m][1] * rq);
                    } else {
                        const int pos = pos_of(row), sel = fq & 1;
                        f32x4 y1[2], y2[2];
#pragma unroll
                        for (int n = 0; n < 2; ++n)
#pragma unroll
                            for (int e = 0; e < 4; ++e) {
                                float c, s; rope_cs(pos, sel * 8 + n * 4 + e, c, s);
                                const float x1 = acc[ai][0][m][n][e] * rq, x2 = acc[ai][1][m][n][e] * rq;
                                y1[n][e] = x1 * c - x2 * s; y2[n][e] = x1 * s + x2 * c;
                            }
                        bf16_t* q = C.Qr() + (unsigned)row * 256 + colw;
                        st_bf16x8(q, y1[0], y1[1]); st_bf16x8(q + 128, y2[0], y2[1]);
                    }
                }
        } else if (mode == 2) {
            f32x4 sv[8]; bool past[8];
#pragma unroll
            for (int i = 0; i < 8; ++i) {
                const int L = row0 + (i >> 2) * 128 + (i & 3) * 16; int tok = L; past[i] = false;
                if (L >= TP) { const int s = L - TP, bb = s / TKS, t = s - bb * TKS; past[i] = t < PAST; tok = past[i] ? 0 : TP + bb * 32 + (t - PAST); }
                sv[i] = *(const f32x4*)(C.ssq_kv() + (unsigned)tok * 4);
            }
#pragma unroll
            for (int ai = 0; ai < 2; ++ai)
#pragma unroll
                for (int m = 0; m < 4; ++m) {
                    const int row = row0 + ai * 128 + m * 16, i = ai * 4 + m;
                    const float rs = past[i] ? 1.0f : rsqrtf(sum4(sv[i]) * (1.0f / 256.0f) + EPS);
#pragma unroll
                    for (int bj = 0; bj < 2; ++bj) st_bf16x8(C.Kn() + (unsigned)row * 512 + pn * 256 + bj * 128 + colw, acc[ai][bj][m][0] * rs, acc[ai][bj][m][1] * rs);
                }
        } else if (mode == 3) {
            f32x4 rs[2][2];
#pragma unroll
            for (int bj = 0; bj < 2; ++bj) {
                f32x4 sv[8]; bool past[8];
#pragma unroll
                for (int i = 0; i < 8; ++i) {
                    const int L = pn * 256 + bj * 128 + colw + i; int tok = L; past[i] = false;
                    if (L >= TP) { const int s = L - TP, bb = s / TKS, t = s - bb * TKS; past[i] = t < PAST; tok = past[i] ? 0 : TP + bb * 32 + (t - PAST); }
                    sv[i] = *(const f32x4*)(C.ssq_kv() + (unsigned)tok * 4);
                }
#pragma unroll
                for (int i = 0; i < 8; ++i) rs[bj][i >> 2][i & 3] = past[i] ? 1.0f : rsqrtf(sum4(sv[i]) * (1.0f / 256.0f) + EPS);
            }
#pragma unroll
            for (int ai = 0; ai < 2; ++ai)
#pragma unroll
                for (int m = 0; m < 4; ++m) {
                    const int row = row0 + ai * 128 + m * 16;
#pragma unroll
                    for (int bj = 0; bj < 2; ++bj) st_bf16x8(C.Vt() + (unsigned)row * LV + pn * 256 + bj * 128 + colw, acc[ai][bj][m][0] * rs[bj][0], acc[ai][bj][m][1] * rs[bj][1]);
                }
        } else if (mode == 4) {
            if (u.pm * 256 < TP) {
                const float* mb = C.mod() + (unsigned)(u.pm >> 5) * 6144;
                f32x4 g1h[2][2], gkh[2][2];
#pragma unroll
                for (int bj = 0; bj < 2; ++bj)
#pragma unroll
                    for (int n = 0; n < 2; ++n) { const int c4 = pn * 256 + bj * 128 + colw + n * 4;
                        g1h[bj][n] = *(const f32x4*)(mb + 2048 + c4); gkh[bj][n] = *(const f32x4*)(C.p.norm_ffn_g + c4) * (*(const f32x4*)(mb + 4096 + c4) + 1.0f); }
#pragma unroll
                for (int ai = 0; ai < 2; ++ai)
#pragma unroll
                    for (int mp = 0; mp < 2; ++mp) {
                        f32x4 xv[2][2][2];
#pragma unroll
                        for (int mm = 0; mm < 2; ++mm) { const float* xr = C.p.x_p + (unsigned)(row0 + ai * 128 + (mp * 2 + mm) * 16) * DM + pn * 256 + colw;
#pragma unroll
                            for (int bj = 0; bj < 2; ++bj) { xv[mm][bj][0] = *(const f32x4*)(xr + bj * 128); xv[mm][bj][1] = *(const f32x4*)(xr + bj * 128 + 4); } }
#pragma unroll
                        for (int mm = 0; mm < 2; ++mm) { const int m = mp * 2 + mm, row = row0 + ai * 128 + m * 16; float s = 0.f;
#pragma unroll
                            for (int bj = 0; bj < 2; ++bj) { const int col = pn * 256 + bj * 128 + colw;
                                const f32x4 xa = xv[mm][bj][0] + g1h[bj][0] * acc[ai][bj][m][0], xb = xv[mm][bj][1] + g1h[bj][1] * acc[ai][bj][m][1];
                                st_bf16x8(C.xb() + (unsigned)row * DM + col, xa, xb); s += dot4(xa) + dot4(xb);
                                st_bf16x8(C.A2() + (unsigned)row * DM + col, xa * gkh[bj][0], xb * gkh[bj][1]); }
                            s += __shfl_xor(s, 16); s += __shfl_xor(s, 32);
                            if (fq == 0) C.ssq_x1()[(unsigned)row * 16 + pn * 4 + wc] = s; }
                        asm volatile("" ::: "memory");
                    }
            } else {
#pragma unroll
            for (int ai = 0; ai < 2; ++ai)
#pragma unroll
                for (int m = 0; m < 4; ++m) {
                    const int row = row0 + ai * 128 + m * 16, b = batch_of(row);
                    const float* xr = row < TP ? C.p.x_p + (unsigned)row * DM : C.p.x_s + (unsigned)(row - TP) * DM;
                    const float* mb = C.mod() + (unsigned)b * 6144; float s = 0.f;
#pragma unroll
                    for (int bj = 0; bj < 2; ++bj) {
                        const int col = pn * 256 + bj * 128 + colw; f32x4 a2[2], xk[2];
#pragma unroll
                        for (int n = 0; n < 2; ++n) {
                            const int c4 = col + n * 4;
                            const f32x4 xv = *(const f32x4*)(xr + c4), g1 = *(const f32x4*)(mb + 2048 + c4), sc2 = *(const f32x4*)(mb + 4096 + c4), gn = *(const f32x4*)(C.p.norm_ffn_g + c4);
                            const f32x4 x1 = xv + g1 * acc[ai][bj][m][n];
                            xk[n] = x1; s += dot4(x1);
                            a2[n] = x1 * gn * (sc2 + 1.0f);
                        }
                        st_bf16x8(C.xb() + (unsigned)row * DM + col, xk[0], xk[1]);
                        st_bf16x8(C.A2() + (unsigned)row * DM + col, a2[0], a2[1]);
                    }
                    s += __shfl_xor(s, 16); s += __shfl_xor(s, 32);
                    if (fq == 0) C.ssq_x1()[(unsigned)row * 16 + pn * 4 + wc] = s;
                }
            }
        } else if (mode == 5) {
            const int colg = pn * 128 + colw;
            float rsv[8]; row_stats8(C.ssq_x1(), row0, fq, 1.0f / 1024.0f, rsv);
            if (u.pm * 256 < TP) {
                f32x4 bgh[2], buh[2];
                { const size_t bo = (unsigned)(u.pm >> 5) * DFF + colg;
#pragma unroll
                  for (int n = 0; n < 2; ++n) { bgh[n] = *(const f32x4*)(C.bg() + bo + n * 4); buh[n] = *(const f32x4*)(C.bu() + bo + n * 4); } }
#pragma unroll
                for (int ai = 0; ai < 2; ++ai)
#pragma unroll
                    for (int m = 0; m < 4; ++m) {
                        const int row = row0 + ai * 128 + m * 16; const float rstd = rsv[ai * 4 + m]; f32x4 hv[2];
#pragma unroll
                        for (int n = 0; n < 2; ++n) {
                            const f32x4 gate = acc[ai][0][m][n] * rstd + bgh[n], up = acc[ai][1][m][n] * rstd + buh[n];
#pragma unroll
                            for (int e = 0; e < 4; ++e) hv[n][e] = silu_f(gate[e]) * up[e];
                        }
                        st_bf16x8(C.hff() + (unsigned)row * DFF + colg, hv[0], hv[1]);
                    }
            } else {
#pragma unroll
                for (int ai = 0; ai < 2; ++ai)
#pragma unroll
                    for (int m = 0; m < 4; ++m) {
                        const int row = row0 + ai * 128 + m * 16; const float rstd = rsv[ai * 4 + m]; f32x4 hv[2];
                        const size_t bo = (unsigned)batch_of(row) * DFF + colg;
#pragma unroll
                        for (int n = 0; n < 2; ++n) {
                            const f32x4 gate = acc[ai][0][m][n] * rstd + *(const f32x4*)(C.bg() + bo + n * 4), up = acc[ai][1][m][n] * rstd + *(const f32x4*)(C.bu() + bo + n * 4);
#pragma unroll
                            for (int e = 0; e < 4; ++e) hv[n][e] = silu_f(gate[e]) * up[e];
                        }
                        st_bf16x8(C.hff() + (unsigned)row * DFF + colg, hv[0], hv[1]);
                    }
            }
        } else if (mode == 6) {
            if (u.pm * 256 < TP) {
                const float* mb = C.mod() + (unsigned)(u.pm >> 5) * 6144 + 5120 + pn * 256 + colw;
                const f32x4 g2a0 = *(const f32x4*)mb, g2b0 = *(const f32x4*)(mb + 4), g2a1 = *(const f32x4*)(mb + 128), g2b1 = *(const f32x4*)(mb + 132);
#pragma unroll
                for (int ai = 0; ai < 2; ++ai) {
                    u32x4 xw[4][2];
#pragma unroll
                    for (int m = 0; m < 4; ++m) { const bf16_t* xr = C.xb() + (unsigned)(row0 + ai * 128 + m * 16) * DM + pn * 256 + colw; xw[m][0] = *(const u32x4*)xr; xw[m][1] = *(const u32x4*)(xr + 128); }
#pragma unroll
                    for (int m = 0; m < 4; ++m) { bf16_t* xr = C.xb() + (unsigned)(row0 + ai * 128 + m * 16) * DM + pn * 256 + colw;
#pragma unroll
                        for (int bj = 0; bj < 2; ++bj) { const u32x4 w = xw[m][bj];
                            const f32x4 xa = (f32x4){__uint_as_float(w.x << 16), __uint_as_float(w.x & 0xffff0000u), __uint_as_float(w.y << 16), __uint_as_float(w.y & 0xffff0000u)};
                            const f32x4 xc = (f32x4){__uint_as_float(w.z << 16), __uint_as_float(w.z & 0xffff0000u), __uint_as_float(w.w << 16), __uint_as_float(w.w & 0xffff0000u)};
                            st_bf16x8(xr + bj * 128, xa + (bj ? g2a1 : g2a0) * acc[ai][bj][m][0], xc + (bj ? g2b1 : g2b0) * acc[ai][bj][m][1]); } }
                    asm volatile("" ::: "memory");
                }
            } else {
#pragma unroll
                for (int ai = 0; ai < 2; ++ai)
#pragma unroll
                    for (int m = 0; m < 4; ++m) {
                        const int row = row0 + ai * 128 + m * 16;
                        const float* mb = C.mod() + (unsigned)batch_of(row) * 6144 + 5120;
#pragma unroll
                        for (int bj = 0; bj < 2; ++bj) {
                            const int col = pn * 256 + bj * 128 + colw; bf16_t* xr = C.xb() + (unsigned)row * DM + col;
                            f32x4 xa, xc; ld_bf16x8(xr, xa, xc);
                            st_bf16x8(xr, xa + *(const f32x4*)(mb + col) * acc[ai][bj][m][0], xc + *(const f32x4*)(mb + col + 4) * acc[ai][bj][m][1]);
                        }
                    }
            }
        } else if (mode == 7) {
#pragma unroll
            for (int ai = 0; ai < 2; ++ai)
#pragma unroll
                for (int m = 0; m < 4; ++m) {
                    float* o = C.part() + ((unsigned)u.kc * 1024 + (unsigned)(row0 + ai * 128 + m * 16)) * 1024 + pn * 256 + colw;
#pragma unroll
                    for (int bj = 0; bj < 2; ++bj) { *(f32x4*)(o + bj * 128) = acc[ai][bj][m][0]; *(f32x4*)(o + bj * 128 + 4) = acc[ai][bj][m][1]; }
                }
        }
    }
};

struct WSrc { const float* W; int ld; int col; };
__device__ __forceinline__ WSrc wsrc(const Ctx& C, int mat, int n) {
    WSrc r; r.W = C.p.w_in; r.ld = 2592; r.col = -1;
    if (mat == 0) {
        if (n < 1024) r.col = n;
        else if (n < 2048) { const int j = (n - 1024) >> 8, c = (n - 1024) & 255; r.col = c < 128 ? 1056 + 128 * j + c : 2080 + 128 * j + (c - 128); }
        else if (n < 2560) r.col = 1568 + (n - 2048);
        else { const int c = n - 2560; if (c < 16) r.col = 1024 + c; else if (c >= 128 && c < 144) r.col = 1040 + (c - 128); }
    } else if (mat == 1) {
        r.W = C.p.w_uq; r.ld = 768;
        if (n < 512) r.col = (n >> 6) * 96 + (n & 63);
        else { const int c = n - 512, half = c >> 7, cc = c & 127; r.col = (cc >> 4) * 96 + 64 + half * 16 + (cc & 15); }
    } else if (mat == 2) { r.W = C.p.w_ukv; r.ld = 1024; r.col = (n >> 6) * 128 + (n & 63); }
    else if (mat == 3) { r.W = C.p.w_ukv; r.ld = 1024; r.col = (n >> 6) * 128 + 64 + (n & 63); }
    else if (mat == 4) { r.W = C.p.w_out; r.ld = 1024; r.col = n; }
    else if (mat == 5) { const int j = n >> 8, c = n & 255; r.ld = 2816; if (c < 128) { r.W = C.p.w_gate; r.col = 128 * j + c; } else { r.W = C.p.w_up; r.col = 128 * j + (c - 128); } }
    else { r.W = C.p.w_down; r.ld = 1024; r.col = n; }
    return r;
}
__device__ __forceinline__ void transpose_item(const Ctx& C, int mat, int K, bf16_t* WT, LAS float* scr, int item, int nblk, int lane_) {
    int lane = lane_; asm volatile("" : "+v"(lane));
    const int kb = item / nblk, nb = item - kb * nblk, k0 = 64 * kb, n0 = 32 * nb;
    const WSrc s = wsrc(C, mat, n0 + (lane & 31));
    float tv[32];
#pragma unroll
    for (int i = 0; i < 32; ++i) { const int kk = 2 * i + (lane >> 5); tv[i] = s.col >= 0 ? s.W[(size_t)(k0 + kk) * s.ld + s.col] : 0.f; }
#pragma unroll
    for (int i = 0; i < 32; ++i) { const int kk = 2 * i + (lane >> 5); scr[kk * 33 + (lane & 31)] = tv[i]; }
    asm volatile("s_waitcnt lgkmcnt(0)" ::: "memory");
    const int c = lane & 7;
#pragma unroll
    for (int j = 0; j < 4; ++j) { const int n = (lane >> 3) + 8 * j; const LAS float* t = scr + (8 * c) * 33 + n;
        u32x4 o; o.x = pk2(t[0 * 33], t[1 * 33]); o.y = pk2(t[2 * 33], t[3 * 33]); o.z = pk2(t[4 * 33], t[5 * 33]); o.w = pk2(t[6 * 33], t[7 * 33]);
        *(u32x4*)(WT + (size_t)(n0 + n) * K + k0 + 8 * c) = o; }
    asm volatile("s_waitcnt lgkmcnt(0)" ::: "memory");
}

template <int ACT>
__device__ __forceinline__ void gemv_item(const Ctx& C, LAS unsigned char* lds, const float* W, int ldw, int n0, const float* bias, float* outp, int ldo, int tid_, int wave, int lane_) {
    int tid = tid_, lane = lane_; asm volatile("" : "+v"(tid), "+v"(lane));
    LAS float* act = (LAS float*)lds + wave * 2560;
    float acc[40];
#pragma unroll
    for (int b = 0; b < 40; ++b) acc[b] = 0.f;
    for (int pass = 0; pass < 2; ++pass) {
        const int kbase = wave * 128 + pass * 64;
        {
            const int k = kbase + lane; float av[40];
#pragma unroll
            for (int bb = 0; bb < 40; ++bb) av[bb] = ACT == 0 ? (bb < 8 ? C.p.c_p[bb * 1024 + k] : C.p.c_s[(bb - 8) * 1024 + k]) : C.mod()[(size_t)bb * 6144 + 3072 + k];
#pragma unroll
            for (int bb = 0; bb < 40; ++bb) { float v = av[bb]; if (ACT == 0) v = v / (1.0f + __expf(-v)); act[lane * 40 + bb] = v; }
        }
        asm volatile("s_waitcnt lgkmcnt(0)" ::: "memory");
        for (int kq = 0; kq < 64; kq += 16) {
        float wv[16];
#pragma unroll
        for (int i = 0; i < 16; ++i) wv[i] = W[(size_t)(kbase + kq + i) * ldw + n0 + lane];
#pragma unroll
        for (int i = 0; i < 16; ++i) {
            const int kk = kq + i; const float w = wv[i];
#pragma unroll
            for (int b4 = 0; b4 < 10; ++b4) { const f32x4 a = *(const LAS f32x4*)(act + kk * 40 + b4 * 4);
                acc[b4 * 4 + 0] += a[0] * w; acc[b4 * 4 + 1] += a[1] * w; acc[b4 * 4 + 2] += a[2] * w; acc[b4 * 4 + 3] += a[3] * w; }
        }
        }
        asm volatile("s_waitcnt lgkmcnt(0)" ::: "memory");
    }
    __syncthreads();
    LAS float* red = (LAS float*)lds;
#pragma unroll
    for (int b = 0; b < 40; ++b) red[(wave * 40 + b) * 64 + lane] = acc[b];
    __syncthreads();
    for (int o = tid; o < 2560; o += 512) { const int b = o >> 6, l = o & 63; float s = bias ? bias[n0 + l] : 0.f;
#pragma unroll
        for (int w = 0; w < 8; ++w) s += red[(w * 40 + b) * 64 + l];
        outp[(size_t)b * ldo + n0 + l] = s; }
    __syncthreads();
}


template <int R>
__device__ __forceinline__ void h1_group(const Ctx& C, int row0, int lane) {
    const float* xr = row0 < TP ? C.p.x_p + (size_t)row0 * DM : C.p.x_s + (size_t)(row0 - TP) * DM;
    const float* mb = C.mod() + (size_t)batch_of(row0) * 6144;
    f32x4 v[R][4]; float s[R];
#pragma unroll
    for (int r = 0; r < R; ++r)
#pragma unroll
        for (int j = 0; j < 4; ++j) v[r][j] = *(const f32x4*)(xr + (size_t)r * DM + 4 * lane + 256 * j);
#pragma unroll
    for (int r = 0; r < R; ++r) s[r] = dot4(v[r][0]) + dot4(v[r][1]) + dot4(v[r][2]) + dot4(v[r][3]);
#pragma unroll
    for (int o = 1; o < 64; o <<= 1) {
#pragma unroll
        for (int r = 0; r < R; ++r) s[r] += __shfl_xor(s[r], o);
    }
#pragma unroll
    for (int r = 0; r < R; ++r) s[r] = rsqrtf(s[r] * (1.0f / 1024.0f) + EPS);
#pragma unroll
    for (int j = 0; j < 4; ++j) {
        const int k = 4 * lane + 256 * j;
        const f32x4 g = *(const f32x4*)(C.p.norm_mix_g + k), sh = *(const f32x4*)(mb + k), sc = *(const f32x4*)(mb + 1024 + k);
        const f32x4 gs = g * (sc + 1.0f);
#pragma unroll
        for (int r = 0; r < R; ++r) {
            const f32x4 hv = v[r][j] * s[r] * gs + sh;
            u32x2 w; w.x = pk2(hv[0], hv[1]); w.y = pk2(hv[2], hv[3]);
            *(u32x2*)(C.h1() + (size_t)(row0 + r) * DM + k) = w;
        }
    }
}


template <int R>
__device__ __forceinline__ void final_group(const Ctx& C, int row0, int lane) {
    const bf16_t* xr = C.xb() + (size_t)row0 * DM + 8 * lane;
    f32x4 v[R][4];
#pragma unroll
    for (int r = 0; r < R; ++r) { ld_bf16x8(xr + (size_t)r * DM, v[r][0], v[r][1]); ld_bf16x8(xr + (size_t)r * DM + 512, v[r][2], v[r][3]); }
    if (row0 >= TP) {
        const float* mb = C.mod() + (size_t)(8 + ((row0 - TP) >> 5)) * 6144 + 5120 + 8 * lane;
        f32x4 a[R][4];
#pragma unroll
        for (int r = 0; r < R; ++r)
#pragma unroll
            for (int j = 0; j < 4; ++j) a[r][j] = (f32x4){0.f, 0.f, 0.f, 0.f};
        for (int kc = 0; kc < 11; ++kc) {
            const float* pp = C.part() + ((size_t)kc * 1024 + (row0 - TP)) * 1024 + 8 * lane;
#pragma unroll
            for (int r = 0; r < R; ++r)
#pragma unroll
                for (int j = 0; j < 4; ++j) a[r][j] += *(const f32x4*)(pp + (size_t)r * 1024 + (j >> 1) * 512 + (j & 1) * 4);
        }
#pragma unroll
        for (int j = 0; j < 4; ++j) { const f32x4 g2 = *(const f32x4*)(mb + (j >> 1) * 512 + (j & 1) * 4);
#pragma unroll
            for (int r = 0; r < R; ++r) v[r][j] += g2 * a[r][j]; }
    }
    float rs[R];
#pragma unroll
    for (int r = 0; r < R; ++r) rs[r] = dot4(v[r][0]) + dot4(v[r][1]) + dot4(v[r][2]) + dot4(v[r][3]);
#pragma unroll
    for (int of = 1; of < 64; of <<= 1) {
#pragma unroll
        for (int r = 0; r < R; ++r) rs[r] += __shfl_xor(rs[r], of);
    }
#pragma unroll
    for (int r = 0; r < R; ++r) rs[r] = rsqrtf(rs[r] * (1.0f / 1024.0f) + EPS);
    float* o = C.p.out + OY + (size_t)row0 * DM + 8 * lane;
#pragma unroll
    for (int j = 0; j < 4; ++j) {
        const int co = (j >> 1) * 512 + (j & 1) * 4;
        const f32x4 g = *(const f32x4*)(C.p.final_g + 8 * lane + co);
#pragma unroll
        for (int r = 0; r < R; ++r) *(f32x4*)(o + (size_t)r * DM + co) = v[r][j] * rs[r] * g;
    }
}

constexpr int KSTR = 208, VSTR = 144, KBYTES = 64 * KSTR, VBYTES = 64 * VSTR, ATB = KBYTES + VBYTES;
#define ATT_THR 40.0f
__device__ __forceinline__ bf16x8 pack8(const f32x16& p, int b) {
    u32x4 w; w.x = pk2(p[b], p[b + 1]); w.y = pk2(p[b + 2], p[b + 3]); w.z = pk2(p[b + 4], p[b + 5]); w.w = pk2(p[b + 6], p[b + 7]); return __builtin_bit_cast(bf16x8, w);
}
__device__ __forceinline__ float xmax32(float x) {
    auto rr = __builtin_amdgcn_permlane32_swap(__float_as_uint(x), __float_as_uint(x), false, false);
    return fmaxf(__uint_as_float(rr[0]), __uint_as_float(rr[1]));
}
__device__ __forceinline__ float xsum32(float x) {
    auto rr = __builtin_amdgcn_permlane32_swap(__float_as_uint(x), __float_as_uint(x), false, false);
    return __uint_as_float(rr[0]) + __uint_as_float(rr[1]);
}
#define ASB() __builtin_amdgcn_sched_barrier(0)
#if defined(PROBE_NOBAR)
#define ATT_BAR() do { if (!nomem) __syncthreads(); } while (0)
#else
#define ATT_BAR() __syncthreads()
#endif
__device__ __forceinline__ float max3f(float a, float b, float c) { float r; asm("v_max3_f32 %0, %1, %2, %3" : "=v"(r) : "v"(a), "v"(b), "v"(c)); return r; }
__device__ __forceinline__ void attn_unit(const Ctx& C, LAS unsigned char* lds, int kvbase, int NT, int wlim, bool half_last, int qrow, int h, int tid, int lane, bool nomem) {
    const int i32 = lane & 31, hi = lane >> 5;
    const int pi = (((i32 >> 2) & 1) << 4) | ((i32 >> 3) << 2) | (i32 & 3);
    const bool active = wlim >= 0;
    bf16x8 qf[6];
#pragma unroll
    for (int kb = 0; kb < 6; ++kb) qf[kb] = (bf16x8){0, 0, 0, 0, 0, 0, 0, 0};
    if (active) {
        const bf16_t* qn = C.Qn() + (size_t)qrow * 512 + h * 64 + hi * 8;
#pragma unroll
        for (int kb = 0; kb < 4; ++kb) qf[kb] = *(const bf16x8*)(qn + kb * 16);
        const bf16_t* qr = C.Qr() + (size_t)qrow * 256 + h * 16 + hi * 8;
        qf[4] = *(const bf16x8*)qr; qf[5] = *(const bf16x8*)(qr + 128);
    }
    f32x16 o0, o1, oL;
#pragma unroll
    for (int r = 0; r < 16; ++r) { o0[r] = 0.f; o1[r] = 0.f; oL[r] = 0.f; }
    float mref = 0.f, lrun = 0.f; bool shifted = false;
    const bf16x8 ones = (bf16x8){0x3F80, 0x3F80, 0x3F80, 0x3F80, 0x3F80, 0x3F80, 0x3F80, 0x3F80};
    const int sr = tid >> 3, sc = tid & 7;
    const bf16_t* gKn = C.Kn() + (size_t)(kvbase + sr) * 512 + h * 64 + sc * 8;
    const bf16_t* gKr = C.krb() + (size_t)(kvbase + (tid >> 2)) * 32 + (tid & 3) * 8;
    const bf16_t* gV = C.Vt() + (size_t)(h * 64 + sr) * LV + kvbase + sc * 8;
    const unsigned dK = sr * KSTR + sc * 16, dKr = (tid >> 2) * KSTR + 128 + (tid & 3) * 16, dV = KBYTES + sr * VSTR + sc * 16;
    const bool do_kr = tid < 256;
    u32x4 rk, rkr = (u32x4){0, 0, 0, 0}, rv;
#define ATT_LOAD(j) do { rk = *(const u32x4*)(gKn + (size_t)(j) * 64 * 512); if (do_kr) rkr = *(const u32x4*)(gKr + (size_t)(j) * 64 * 32); rv = *(const u32x4*)(gV + (size_t)(j) * 64); } while (0)
#define ATT_STORE(slot) do { LAS unsigned char* bb_ = lds + (slot) * ATB; *(LAS u32x4*)(bb_ + dK) = rk; if (do_kr) *(LAS u32x4*)(bb_ + dKr) = rkr; *(LAS u32x4*)(bb_ + dV) = rv; } while (0)
    ATT_LOAD(0); ATT_STORE(0);
    if (NT > 1) { ATT_LOAD(1); ATT_STORE(1); }
    __syncthreads();
    const unsigned kfo = pi * KSTR + hi * 16, vfo = KBYTES + pi * VSTR + hi * 32;
    f32x16 sA0, sA1, sB0, sB1;
    bf16x8 pb[4];
#pragma unroll
    for (int c = 0; c < 4; ++c) pb[c] = (bf16x8){0, 0, 0, 0, 0, 0, 0, 0};
    if (active) {
        const LAS unsigned char* ka = lds + kfo;
#pragma unroll
        for (int kb = 0; kb < 6; ++kb) {
            const bf16x8 k0 = *(const LAS bf16x8*)(ka + kb * 32), k1 = *(const LAS bf16x8*)(ka + 32 * KSTR + kb * 32);
            sA0 = __builtin_amdgcn_mfma_f32_32x32x16_bf16(k0, qf[kb], kb == 0 ? oL : sA0, 0, 0, 0);
            sA1 = __builtin_amdgcn_mfma_f32_32x32x16_bf16(k1, qf[kb], kb == 0 ? oL : sA1, 0, 0, 0);
        }
    }
#define ATT_VF_LO(va) do { vf[0] = *(const LAS bf16x8*)(va); vf[1] = *(const LAS bf16x8*)((va) + 32 * VSTR); vf[2] = *(const LAS bf16x8*)((va) + 16); vf[3] = *(const LAS bf16x8*)((va) + 32 * VSTR + 16); } while (0)
#define ATT_VF_HI(va) do { vf[0] = *(const LAS bf16x8*)((va) + 64); vf[1] = *(const LAS bf16x8*)((va) + 32 * VSTR + 64); vf[2] = *(const LAS bf16x8*)((va) + 80); vf[3] = *(const LAS bf16x8*)((va) + 32 * VSTR + 80); } while (0)
#define ATT_PVMMA(i) do { if ((i) & 1) o1 = __builtin_amdgcn_mfma_f32_32x32x16_bf16(vf[(i) & 3], pb[(i) >> 1], o1, 0, 0, 0); else o0 = __builtin_amdgcn_mfma_f32_32x32x16_bf16(vf[(i) & 3], pb[(i) >> 1], o0, 0, 0, 0); } while (0)
#define ATT_EXP4(SA0, SA1, i) do { if ((i) < 4) { _Pragma("unroll") for (int r = 4 * (i); r < 4 * (i) + 4; ++r) SA0[r] = __builtin_amdgcn_exp2f(SA0[r]); asm volatile("" : "+v"(SA0)); } \
                                   else { _Pragma("unroll") for (int r = 4 * ((i) - 4); r < 4 * ((i) - 4) + 4; ++r) SA1[r] = __builtin_amdgcn_exp2f(SA1[r]); asm volatile("" : "+v"(SA1)); } } while (0)
#define ATT_EXP2(SA0, SA1, j) do { if ((j) < 8) { SA0[2 * (j)] = __builtin_amdgcn_exp2f(SA0[2 * (j)]); SA0[2 * (j) + 1] = __builtin_amdgcn_exp2f(SA0[2 * (j) + 1]); asm volatile("" : "+v"(SA0)); } \
                                   else { SA1[2 * ((j) - 8)] = __builtin_amdgcn_exp2f(SA1[2 * ((j) - 8)]); SA1[2 * ((j) - 8) + 1] = __builtin_amdgcn_exp2f(SA1[2 * ((j) - 8) + 1]); asm volatile("" : "+v"(SA1)); } } while (0)
#define ATT_MAXUPD(SA0, SA1, t_) \
    if (half_last && (t_) == NT - 1) { asm volatile("" ::: "memory"); _Pragma("unroll") for (int r = 0; r < 16; ++r) SA1[r] = -INFINITY; } \
    float mxa = max3f(SA0[0], SA0[1], SA0[2]), mxb = max3f(SA0[4], SA0[5], SA0[6]), mxc = max3f(SA1[0], SA1[1], SA1[2]), mxd = max3f(SA1[4], SA1[5], SA1[6]); \
    mxa = max3f(mxa, SA0[3], SA0[8]); mxb = max3f(mxb, SA0[7], SA0[9]); mxc = max3f(mxc, SA1[3], SA1[8]); mxd = max3f(mxd, SA1[7], SA1[9]); \
    mxa = max3f(mxa, SA0[10], SA0[11]); mxb = max3f(mxb, SA0[12], SA0[13]); mxc = max3f(mxc, SA1[10], SA1[11]); mxd = max3f(mxd, SA1[12], SA1[13]); \
    mxa = max3f(mxa, SA0[14], SA0[15]); mxc = max3f(mxc, SA1[14], SA1[15]); \
    float mx = max3f(mxa, mxb, mxc); mx = fmaxf(mx, mxd); \
    mx = xmax32(mx); \
    const bool upd = __any(mx > ATT_THR || ((t_) == 0 && mx < -ATT_THR)); float alpha = 1.0f; \
    if (upd) { const float delta = (mx > ATT_THR || ((t_) == 0 && mx < -ATT_THR)) ? mx : 0.f; mref += delta; alpha = __builtin_amdgcn_exp2f(-delta); shifted = true; \
        _Pragma("unroll") for (int r = 0; r < 16; ++r) { SA0[r] -= delta; SA1[r] -= delta; } }
#define ATT_QK_SUM(SA0, SA1, SB0, SB1, t_, TAILEXP) do { const LAS unsigned char* ka = lds + (((t_) + 1) & 3) * ATB + kfo; \
      bf16x8 kf[4]; kf[0] = *(const LAS bf16x8*)(ka); kf[1] = *(const LAS bf16x8*)(ka + 32 * KSTR); kf[2] = *(const LAS bf16x8*)(ka + 32); kf[3] = *(const LAS bf16x8*)(ka + 32 * KSTR + 32); \
      _Pragma("unroll") for (int kb = 0; kb < 6; ++kb) { const int s_ = (kb & 1) * 2; \
        if (kb == 0) { if (shifted) { f32x16 cinit; { const float nm = -mref; _Pragma("unroll") for (int r = 0; r < 16; ++r) cinit[r] = nm; } \
                SB0 = __builtin_amdgcn_mfma_f32_32x32x16_bf16(kf[0], qf[0], cinit, 0, 0, 0); SB1 = __builtin_amdgcn_mfma_f32_32x32x16_bf16(kf[1], qf[0], cinit, 0, 0, 0); } \
            else { const f32x16 z16 = {0.f, 0.f, 0.f, 0.f, 0.f, 0.f, 0.f, 0.f, 0.f, 0.f, 0.f, 0.f, 0.f, 0.f, 0.f, 0.f}; \
                SB0 = __builtin_amdgcn_mfma_f32_32x32x16_bf16(kf[0], qf[0], z16, 0, 0, 0); SB1 = __builtin_amdgcn_mfma_f32_32x32x16_bf16(kf[1], qf[0], z16, 0, 0, 0); } \
            if (TAILEXP) { ATT_EXP2(SA0, SA1, 12); ATT_EXP2(SA0, SA1, 13); } } \
        else { SB0 = __builtin_amdgcn_mfma_f32_32x32x16_bf16(kf[s_], qf[kb], SB0, 0, 0, 0); \
               if (TAILEXP && kb == 1) ATT_EXP2(SA0, SA1, 14); \
               SB1 = __builtin_amdgcn_mfma_f32_32x32x16_bf16(kf[s_ + 1], qf[kb], SB1, 0, 0, 0); \
               if (TAILEXP && kb == 1) ATT_EXP2(SA0, SA1, 15); } \
        if (kb + 2 < 6) { kf[s_] = *(const LAS bf16x8*)(ka + (kb + 2) * 32); kf[s_ + 1] = *(const LAS bf16x8*)(ka + 32 * KSTR + (kb + 2) * 32); } \
        if (kb >= 1 && kb < 5) { const int c_ = kb - 1; if (c_ < 2) { pb[c_] = pack8(SA0, (c_ & 1) * 8); _Pragma("unroll") for (int r = (c_ & 1) * 8; r < (c_ & 1) * 8 + 8; ++r) lrun += SA0[r]; } else { pb[c_] = pack8(SA1, (c_ & 1) * 8); _Pragma("unroll") for (int r = (c_ & 1) * 8; r < (c_ & 1) * 8 + 8; ++r) lrun += SA1[r]; } } \
        ASB(); } \
      } while (0)
#define ATT_FIRST(SA0, SA1, SB0, SB1) do { const bool ld2 = 2 < NT && !nomem; if (ld2) ATT_LOAD(2); \
    { ATT_MAXUPD(SA0, SA1, 0) (void)alpha; } \
    _Pragma("unroll") for (int i = 0; i < 8; ++i) ATT_EXP4(SA0, SA1, i); \
    ATT_BAR(); if (ld2) ATT_STORE(2); \
    ATT_QK_SUM(SA0, SA1, SB0, SB1, 0, false); ATT_BAR(); } while (0)
#define ATT_FULL(SA0, SA1, SB0, SB1, t) do { const int t_ = (t); const bool ld2 = t_ + 2 < NT && !nomem; if (ld2) ATT_LOAD(t_ + 2); \
    bf16x8 vf[4]; const LAS unsigned char* va = lds + ((t_ + 3) & 3) * ATB + vfo; ATT_VF_LO(va); \
    ATT_MAXUPD(SA0, SA1, t_) \
    ASB(); \
    _Pragma("unroll") for (int i = 0; i < 8; ++i) { ATT_PVMMA(i); if (i < 4) vf[i] = *(const LAS bf16x8*)((va) + 64 + (i >> 1) * 16 + (i & 1) * 32 * VSTR); ATT_EXP2(SA0, SA1, i + (i >> 1)); ASB(); \
        if (i & 1) { ATT_EXP2(SA0, SA1, i + (i >> 1) + 1); ASB(); } } \
    if (upd) { lrun *= alpha; _Pragma("unroll") for (int r = 0; r < 16; ++r) { o0[r] *= alpha; o1[r] *= alpha; } } \
    ATT_BAR(); if (ld2) ATT_STORE((t_ + 2) & 3); \
    ATT_QK_SUM(SA0, SA1, SB0, SB1, t_, true); ATT_BAR(); } while (0)
#define ATT_LAST(t) do { const int t_ = (t); const bool ld2 = t_ + 2 < NT && !nomem; if (ld2) ATT_LOAD(t_ + 2); \
    bf16x8 vf[4]; const LAS unsigned char* va = lds + ((t_ + 3) & 3) * ATB + vfo; ATT_VF_LO(va); \
    _Pragma("unroll") for (int i = 0; i < 8; ++i) { ATT_PVMMA(i); if (i < 4) vf[i] = *(const LAS bf16x8*)((va) + 64 + (i >> 1) * 16 + (i & 1) * 32 * VSTR); } \
    ATT_BAR(); if (ld2) ATT_STORE((t_ + 2) & 3); ATT_BAR(); } while (0)
#define ATT_IDLE(t) do { const int t_ = (t); const bool ld2 = t_ + 2 < NT && !nomem; if (ld2) ATT_LOAD(t_ + 2); ATT_BAR(); if (ld2) ATT_STORE((t_ + 2) & 3); ATT_BAR(); } while (0)
    const bool grpB = tid >= 256;
    if (grpB) __syncthreads();
    int t = 0;
    if (active) {
        ATT_FIRST(sA0, sA1, sB0, sB1); t = 1;
        while (t <= wlim) {
            ATT_FULL(sB0, sB1, sA0, sA1, t); ++t;
            if (t > wlim) break;
            ATT_FULL(sA0, sA1, sB0, sB1, t); ++t;
        }
        ATT_LAST(t); ++t;
    }
    for (; t <= NT; ++t) ATT_IDLE(t);
    if (!grpB) __syncthreads();
    __syncthreads();
    if (active && !nomem) {
        const float inv = 1.0f / xsum32(lrun);
        bf16_t* op = C.mix() + (size_t)qrow * DM + h * 64 + hi * 16;
        f32x4 a, b;
        a = (f32x4){o0[0], o0[1], o0[2], o0[3]} * inv; b = (f32x4){o0[4], o0[5], o0[6], o0[7]} * inv; st_bf16x8(op, a, b);
        a = (f32x4){o0[8], o0[9], o0[10], o0[11]} * inv; b = (f32x4){o0[12], o0[13], o0[14], o0[15]} * inv; st_bf16x8(op + 8, a, b);
        a = (f32x4){o1[0], o1[1], o1[2], o1[3]} * inv; b = (f32x4){o1[4], o1[5], o1[6], o1[7]} * inv; st_bf16x8(op + 32, a, b);
        a = (f32x4){o1[8], o1[9], o1[10], o1[11]} * inv; b = (f32x4){o1[12], o1[13], o1[14], o1[15]} * inv; st_bf16x8(op + 40, a, b);
    }
#undef ATT_FIRST
#undef ATT_FULL
#undef ATT_LAST
#undef ATT_IDLE
#undef ATT_MAXUPD
#undef ATT_QK_SUM
#undef ATT_LOAD
#undef ATT_STORE
}

#define XB_TMO      128
#define XB_XCNT(j)  (256  + 64 * (j))
#define XB_XSUB(j)  (1280 + 64 * (j))
#define XB_XGEN(j)  (2304 + 64 * (j))
#define XB_TOP      3328
#define XB_TOPGEN   3392
#define XCD_BAR_WORDS 3456
#define XB_SPIN_CAP (1u << 18)

__device__ __forceinline__ unsigned xb_ld(unsigned* p)              { return __hip_atomic_load(p, __ATOMIC_RELAXED, __HIP_MEMORY_SCOPE_AGENT); }
__device__ __forceinline__ unsigned xb_add(unsigned* p, unsigned v) { return __hip_atomic_fetch_add(p, v, __ATOMIC_RELAXED, __HIP_MEMORY_SCOPE_AGENT); }
__device__ __forceinline__ unsigned xb_xcc_id() { return (unsigned)__builtin_amdgcn_s_getreg((3 << 11) | 20) & 0xFu; }
#define XB_SPIN(cond, bar) do { unsigned _sp = 0; while (cond) { __builtin_amdgcn_s_sleep(1); \
    if ((++_sp & 255u) == 0u) { if (xb_ld(&(bar)[XB_TMO])) break; if (_sp > XB_SPIN_CAP) { atomicAdd(&(bar)[XB_TMO], 1u); break; } } } } while (0)

struct XcdBarrier {
    unsigned* bar; unsigned x;
    volatile LAS unsigned* st;
};

__device__ __forceinline__ XcdBarrier xcd_barrier_post(unsigned* bar, volatile LAS unsigned* st) {
    XcdBarrier b; b.bar = bar; b.x = xb_xcc_id(); b.st = st;
    if (threadIdx.x == 0) (void)xb_add(&bar[XB_XCNT(b.x)], 1u);
    return b;
}
__device__ __forceinline__ void xcd_barrier_complete(unsigned* bar, unsigned x, unsigned& nloc, unsigned& nx) {
    const unsigned G = gridDim.x * gridDim.y * gridDim.z;
    unsigned sum, cnt, mine, sp = 0u;
    for (;;) {
        sum = 0u; cnt = 0u; mine = 0u;
#pragma unroll
        for (unsigned j = 0; j < 16; ++j) { const unsigned c = xb_ld(&bar[XB_XCNT(j)]); sum += c; cnt += (c > 0u) ? 1u : 0u; mine = (j == x) ? c : mine; }
        if (sum == G) break;
        __builtin_amdgcn_s_sleep(1);
        if ((++sp & 255u) == 0u) { if (xb_ld(&bar[XB_TMO])) break; if (sp > XB_SPIN_CAP) { atomicAdd(&bar[XB_TMO], 1u); break; } }
    }
    nloc = mine > 0u ? mine : 1u; nx = cnt > 0u ? cnt : 1u;
}

__device__ __forceinline__ void xcd_barrier(const XcdBarrier& b) {
    asm volatile("s_waitcnt vmcnt(0)" ::: "memory");
    __syncthreads();
    if (threadIdx.x == 0) {
        unsigned* bar = b.bar;
        __builtin_amdgcn_s_waitcnt(0);
        unsigned nloc = b.st[0], nx = b.st[1];
        if (nloc == 0u) { xcd_barrier_complete(bar, b.x, nloc, nx); b.st[0] = nloc; b.st[1] = nx; }
        const unsigned old = xb_add(&bar[XB_XSUB(b.x)], 1u);
        const unsigned gen = old / nloc;
        if (old + 1u == (gen + 1u) * nloc) {
            __builtin_amdgcn_fence(__ATOMIC_RELEASE, "agent");
            asm volatile("s_waitcnt vmcnt(0)" ::: "memory");
            const unsigned og = xb_add(&bar[XB_TOP], 1u);
            const unsigned tg = og / nx;
            if (og + 1u == (tg + 1u) * nx) xb_add(&bar[XB_TOPGEN], 1u);
            else XB_SPIN(xb_ld(&bar[XB_TOPGEN]) == tg, bar);
            __builtin_amdgcn_fence(__ATOMIC_ACQUIRE, "agent");
            xb_add(&bar[XB_XGEN(b.x)], 1u);
            asm volatile("s_waitcnt vmcnt(0)" ::: "memory");
        } else {
            XB_SPIN(xb_ld(&bar[XB_XGEN(b.x)]) == gen, bar);
            __builtin_amdgcn_fence(__ATOMIC_ACQUIRE, "agent");
            asm volatile("s_waitcnt vmcnt(0)" ::: "memory");
        }
    }
    __syncthreads();
}

__global__ void __launch_bounds__(512, 2) fwd_kernel(Params prm) {
    extern __shared__ __attribute__((aligned(16))) unsigned char lds_raw[];
    cg::grid_group grid = cg::this_grid();
    LAS unsigned char* lds = (LAS unsigned char*)lds_raw;
#define FRESH_TID() int tid = threadIdx.x; asm volatile("" : "+v"(tid)); const int lane = tid & 63, wave = __builtin_amdgcn_readfirstlane(tid >> 6); \
    const int gw = vcu * 8 + wave, NGW = G * 8; const size_t gtid = (size_t)bid * 512 + tid, gsz = (size_t)G * 512; (void)lane; (void)gw; (void)NGW; (void)gtid; (void)gsz
    const int G = gridDim.x, bid = blockIdx.x;
    const int vcu = (G % 8 == 0) ? (bid % 8) * (G / 8) + bid / 8 : bid;
    Ctx C; C.p = prm;
    volatile LAS unsigned* bst = (volatile LAS unsigned*)(lds + 131072 + 64);
    if (threadIdx.x < 2) bst[threadIdx.x] = 0u;
    __syncthreads();
    const XcdBarrier xbar = xcd_barrier_post((unsigned*)(prm.ws + OFF_BAR), bst);
#define GRID_BAR() xcd_barrier(xbar)

#ifndef REP_PRO
#define REP_PRO 1
#endif
    for (int rep0 = 0; rep0 < REP_PRO; ++rep0) {
    { FRESH_TID();
    for (int it = bid; it < 96; it += G) gemv_item<0>(C, lds, prm.w_ada, 6144, it * 64, prm.b_ada, C.mod(), 6144, tid, wave, lane);
    {
        LAS float* scr = (LAS float*)lds + wave * (64 * 33);
        constexpr int I0 = 16 * 88, I1 = 12 * 24, I2 = 4 * 16, I3 = 4 * 16, I4 = 16 * 32, I5 = 16 * 176, I6 = 44 * 32;
        constexpr int NIT = I0 + I1 + I2 + I3 + I4 + I5 + I6;
        for (int it = gw; it < NIT; it += NGW) {
            int r = it, mat, K, nblk; bf16_t* WT;
            if (r < I0) { mat = 0; K = 1024; nblk = 88; WT = C.Win(); }
            else if ((r -= I0) < I1) { mat = 1; K = 768; nblk = 24; WT = C.Wuq(); }
            else if ((r -= I1) < I2) { mat = 2; K = 256; nblk = 16; WT = C.Wkn(); }
            else if ((r -= I2) < I3) { mat = 3; K = 256; nblk = 16; WT = C.Wv(); }
            else if ((r -= I3) < I4) { mat = 4; K = 1024; nblk = 32; WT = C.Wout(); }
            else if ((r -= I4) < I5) { mat = 5; K = 1024; nblk = 176; WT = C.Wgu(); }
            else { r -= I5; mat = 6; K = 2816; nblk = 32; WT = C.Wdn(); }
            transpose_item(C, mat, K, WT, scr, r, nblk, lane);
        }
        for (size_t idx0 = gtid; idx0 < (size_t)32 * PAST * 32; idx0 += 4 * gsz) {
            f32x4 a[4], c[4];
#pragma unroll
            for (int u = 0; u < 4; ++u) { const size_t idx = idx0 + u * gsz; if (idx < (size_t)32 * PAST * 32) { const float* s = prm.cache_lat + idx * 8; a[u] = *(const f32x4*)s; c[u] = *(const f32x4*)(s + 4); } }
#pragma unroll
            for (int u = 0; u < 4; ++u) { const size_t idx = idx0 + u * gsz; if (idx < (size_t)32 * PAST * 32) {
                const int bt = (int)(idx >> 5), c8 = (int)(idx & 31) * 8, bb = bt >> 11, t = bt & 2047;
                st_bf16x8(C.lat() + (size_t)(TP + bb * TKS + t) * 256 + c8, a[u], c[u]); } }
        }
        for (size_t idx = gtid; idx < (size_t)32 * PAST * 4; idx += gsz) {
            const int bt = (int)(idx >> 2), c8 = (int)(idx & 3) * 8, bb = bt >> 11, t = bt & 2047;
            const float* s = prm.cache_kr + (size_t)bt * 32 + c8;
            st_bf16x8(C.krb() + (size_t)(TP + bb * TKS + t) * 32 + c8, *(const f32x4*)s, *(const f32x4*)(s + 4));
        }
    }
    }
    if (prm.ws == nullptr) grid.sync();
    GRID_BAR();

    { FRESH_TID();
    for (int it = bid; it < 88; it += G) {
        const bool up = it >= 44;
        gemv_item<1>(C, lds, up ? prm.w_up : prm.w_gate, 2816, (up ? it - 44 : it) * 64, nullptr, up ? C.bu() : C.bg(), 2816, tid, wave, lane);
    }
    for (int row4 = gw * 4; row4 < TP; row4 += NGW * 4) h1_group<4>(C, row4, lane);
    for (int row = TP + gw; row < MT; row += NGW) h1_group<1>(C, row, lane);
    }
    GRID_BAR();
    }

#ifdef PROBE_SYNC
    for (int i = 0; i < PROBE_SYNC; ++i) GRID_BAR();
#endif
#pragma nounroll
    for (int job = 0; job < 8; ++job) {
        pg8::Gemm g; int rot = 0;
        if (job == 0) { g.A = C.h1(); g.Bt = C.Win(); g.M = MT; g.N = NIN; g.K = 1024; }
        else if (job == 1) { g.A = C.cq(); g.Bt = C.Wuq(); g.M = MT; g.N = 768; g.K = 768; }
        else if (job == 2) { g.A = C.lat(); g.Bt = C.Wkn(); g.M = LROWS; g.N = 512; g.K = 256; rot = 12; }
        else if (job == 3) { g.A = C.Wv(); g.Bt = C.lat(); g.M = 512; g.N = LROWS; g.K = 256; rot = 20; }
        else if (job == 4) { g.A = C.mix(); g.Bt = C.Wout(); g.M = MT; g.N = 1024; g.K = 1024; }
        else if (job == 5) { g.A = C.A2(); g.Bt = C.Wgu(); g.M = MT; g.N = NGU; g.K = 1024; }
        else if (job == 6) { g.A = C.hff(); g.Bt = C.Wdn(); g.M = TP; g.N = 1024; g.K = 2816; }
        else { g.A = C.hff() + (size_t)TP * DFF; g.Bt = C.Wdn(); g.M = TS; g.N = 1024; g.K = 256; rot = 40; }
        g.ld = g.K; if (job == 7) g.ld = DFF;
        pg8::StaticOrder S; S.init(g.M, g.N, G, (bid + G - rot % G) % G);
        if (job == 7) S.split = 11;
        if (job == 5 || job == 1 || job == 2) S.rev = 1;
        EpiAll E{C, job};
#ifndef REPMASK
#define REPMASK 0
#endif
        const int nrep = 1 + ((REPMASK >> job) & 1);
#pragma nounroll
        for (int rep = 0; rep < nrep; ++rep) {
#ifdef REP_NOEPI
        if (rep == 1) E.mode = 99;
#endif
        pg8::gemm_phase<EpiAll, pg8::StaticOrder, true, true>(lds, g, S, E);
        }
        if (job == 1 || job == 2 || job == 6) continue;
        if (job == 3) {
            { FRESH_TID();
            {
                const int c8 = (int)(gtid & 63) * 8;
                float w0[8], w1[8], w2[8], cb[8];
#pragma unroll
                for (int i = 0; i < 8; ++i) { w0[i] = prm.conv_w[c8 + i]; w1[i] = prm.conv_w[512 + c8 + i]; w2[i] = prm.conv_w[1024 + c8 + i]; cb[i] = prm.conv_b[c8 + i]; }
                for (int q = (int)(gtid >> 6); q < MT / 4; q += (int)(gsz >> 6)) {
                    const int row = q * 4, t0 = row < TP ? (row & 8191) : ((row - TP) & 31);
                    u32x4 gw_[6], gq_[4];
#pragma unroll
                    for (int r = 0; r < 4; ++r) { gw_[2 + r] = *(const u32x4*)(C.gi() + (size_t)(row + r) * 512 + c8); gq_[r] = *(const u32x4*)(C.gb() + (size_t)(row + r) * 512 + c8); }
                    float e[6][8];
                    if (t0 != 0) { gw_[0] = *(const u32x4*)(C.gi() + (size_t)(row - 2) * 512 + c8); gw_[1] = *(const u32x4*)(C.gi() + (size_t)(row - 1) * 512 + c8); }
                    else { gw_[0] = (u32x4){0, 0, 0, 0}; gw_[1] = (u32x4){0, 0, 0, 0}; }
#pragma unroll
                    for (int r = 0; r < 6; ++r)
#pragma unroll
                        for (int i = 0; i < 4; ++i) { e[r][2 * i] = __uint_as_float(gw_[r][i] << 16); e[r][2 * i + 1] = __uint_as_float(gw_[r][i] & 0xffff0000u); }
                    if (t0 == 0 && row >= TP) {
                        const float* sc = prm.state_conv + (size_t)((row - TP) >> 5) * 1024 + c8;
#pragma unroll
                        for (int i = 0; i < 8; ++i) { e[0][i] = sc[i]; e[1][i] = sc[512 + i]; }
                    }
#pragma unroll
                    for (int r = 0; r < 4; ++r) {
                        float y[8];
#pragma unroll
                        for (int i = 0; i < 4; ++i) {
                            const float g0 = __uint_as_float(gq_[r][i] << 16), g1 = __uint_as_float(gq_[r][i] & 0xffff0000u);
                            y[2 * i] = g0 * (w0[2 * i] * e[r][2 * i] + w1[2 * i] * e[r + 1][2 * i] + w2[2 * i] * e[r + 2][2 * i] + cb[2 * i]);
                            y[2 * i + 1] = g1 * (w0[2 * i + 1] * e[r][2 * i + 1] + w1[2 * i + 1] * e[r + 1][2 * i + 1] + w2[2 * i + 1] * e[r + 2][2 * i + 1] + cb[2 * i + 1]);
                        }
                        st_bf16x8(C.mix() + (size_t)(row + r) * DM + 512 + c8, (f32x4){y[0], y[1], y[2], y[3]}, (f32x4){y[4], y[5], y[6], y[7]});
                    }
                }
            }
            {
                for (int row8 = gw * 8; row8 < MT; row8 += NGW * 8) {
                    float* o = C.p.out + (row8 < TP ? OLP + (size_t)row8 * 256 : OLS + (size_t)(row8 - TP) * 256) + lane * 4;
                    const bf16_t* src = C.lat() + (size_t)latrow_of(row8) * 256 + lane * 4;
                    u32x2 w[8]; f32x4 sv[8];
#pragma unroll
                    for (int r = 0; r < 8; ++r) { w[r] = *(const u32x2*)(src + r * 256); sv[r] = *(const f32x4*)(C.ssq_kv() + (size_t)(row8 + r) * 4); }
#pragma unroll
                    for (int r = 0; r < 8; ++r) { const float rs = rsqrtf(sum4(sv[r]) * (1.0f / 256.0f) + EPS);
                        *(f32x4*)(o + r * 256) = (f32x4){__uint_as_float(w[r].x << 16), __uint_as_float(w[r].x & 0xffff0000u), __uint_as_float(w[r].y << 16), __uint_as_float(w[r].y & 0xffff0000u)} * rs; }
                }
            }
            }
            GRID_BAR();
            FRESH_TID();
#ifndef REP_ATTN
#define REP_ATTN 1
#endif
            for (int rep = 0; rep < REP_ATTN; ++rep)
            for (int it = vcu; it < 1024 + 256; it += G) {
                const int nsub = it < 1024 ? 2 : 1;
                for (int sub = 0; sub < nsub; ++sub) {
                    int kvbase, NT, wlim, qrow, h; bool half_last;
                    if (it < 1024) { const int bh = it >> 4, s = it & 15, qt = sub ? 31 - s : s, b = bh >> 3; h = bh & 7;
                        kvbase = b * 8192; NT = 4 * qt + 4; wlim = 4 * qt + (wave >> 1); half_last = false; qrow = b * 8192 + 256 * qt + 32 * wave + (lane & 31); }
                    else { const int su = it - 1024, b = su >> 3; h = su & 7;
                        kvbase = TP + b * TKS; NT = 33; wlim = wave == 0 ? 32 : -1; half_last = true; qrow = TP + b * 32 + (lane & 31); }
#if defined(PROBE_ATT) && PROBE_ATT == 2
                    if (rep == 1) wlim = -1;
#endif
#if defined(PROBE_ATT) && PROBE_ATT == 1
                    attn_unit(C, lds, kvbase, NT, wlim, half_last, qrow, h, tid, lane, rep == 1);
#else
                    attn_unit(C, lds, kvbase, NT, wlim, half_last, qrow, h, tid, lane, false);
#endif
                }
            }
        }
        GRID_BAR();
    }
    FRESH_TID();
    for (int row4 = gw * 4; row4 < TP; row4 += NGW * 4) final_group<4>(C, row4, lane);
    for (int row = TP + gw; row < MT; row += NGW) final_group<1>(C, row, lane);
}

extern "C" void kernel_launch(void* const* d_in, const int* in_sizes, int n_in, void* d_out, int out_size, void* d_ws, size_t ws_size, hipStream_t stream) {
    static int grid = 0;
    if (grid == 0) {
        int dev = 0, cus = 0, per_cu = 0;
        if (n_in != 23 || ws_size < WS_NEED) { fprintf(stderr, "kernel_launch: unexpected inputs (n_in %d, ws %zu)\n", n_in, ws_size); grid = -1; return; }
        hipGetDevice(&dev);
        hipDeviceGetAttribute(&cus, hipDeviceAttributeMultiprocessorCount, dev);
        hipFuncSetAttribute((const void*)fwd_kernel, hipFuncAttributeMaxDynamicSharedMemorySize, LDS_BYTES);
        hipOccupancyMaxActiveBlocksPerMultiprocessor(&per_cu, (const void*)fwd_kernel, 512, LDS_BYTES);
        if (per_cu < 1) per_cu = 1;
        grid = cus * per_cu;
        (void)hipGetLastError();
    }
    if (grid < 0) return;
    if (hipMemsetAsync((char*)d_ws + OFF_BAR, 0, 3456 * 4, stream) != hipSuccess) { fprintf(stderr, "kernel_launch: memset of the barrier words failed\n"); return; }
    Params p{};
    const float** f = (const float**)&p;
    for (int i = 0; i < 23; ++i) f[i] = (const float*)d_in[i];
    p.out = (float*)d_out; p.ws = (unsigned char*)d_ws;
    void* args[] = {&p};
    hipError_t e = hipLaunchCooperativeKernel((const void*)fwd_kernel, dim3(grid), dim3(512), args, LDS_BYTES, stream);
    if (e != hipSuccess) fprintf(stderr, "cooperative launch failed: %s (grid %d)\n", hipGetErrorString(e), grid);
}
```
